# Optimizing an MI355X kernel written in HIP

```python
import jax, jax.numpy as jnp
from jax import lax
import numpy as np

D_MODEL = 1024
BATCH = 8
SEQ = 4096
DEPTH = 2

CHUNK = 64
LN_EPS = 1e-5
GMLP_HEADS = 4
GMLP_WIDTH = D_MODEL
GMLP_HEAD_DIM = GMLP_WIDTH // GMLP_HEADS
GMLP_BLOCK = 128
POOL_WINDOWS = (2, 4, 8, 16)
POOL_GROUPS = len(POOL_WINDOWS)
POOL_WIDTH = D_MODEL
POOL_GROUP_DIM = POOL_WIDTH // POOL_GROUPS
EVEN_IN = 3 * GMLP_WIDTH + 2 * POOL_WIDTH
EVEN_MIX = GMLP_WIDTH + POOL_WIDTH
MLA_HEADS = 16
MLA_NOPE = 128
MLA_ROPE = 64
MLA_V = 128
MLA_Q_RANK = 256
MLA_KV_RANK = 128
MLA_WIDTH = MLA_HEADS * MLA_V
ODD_IN = MLA_Q_RANK + MLA_KV_RANK + MLA_ROPE + MLA_WIDTH
ROPE_THETA = 10000.0
Q_BLOCK = 128
ATTN_SCALE = (MLA_NOPE + MLA_ROPE) ** -0.5
DEEPNORM_ALPHA = (2.0 * DEPTH) ** 0.25
DEEPNORM_BETA = (8.0 * DEPTH) ** -0.25
N_EVEN = (DEPTH + 1) // 2
N_ODD = DEPTH // 2

kernel_name = "hybrid_gmlp_pool_mla_deepnorm_adaln"


def layer_norm(x, g, b):
    xf = x.astype(jnp.float32)
    mu = jnp.mean(xf, axis=-1, keepdims=True)
    var = jnp.mean(jnp.square(xf - mu), axis=-1, keepdims=True)
    return ((xf - mu) * lax.rsqrt(var + LN_EPS) * g + b).astype(x.dtype)


def rms_norm(x, g):
    xf = x.astype(jnp.float32)
    ms = jnp.mean(jnp.square(xf), axis=-1, keepdims=True)
    return (xf * lax.rsqrt(ms + LN_EPS) * g).astype(x.dtype)


def rope_cos_sin(positions):
    inv = 1.0 / (ROPE_THETA ** (jnp.arange(0, MLA_ROPE, 2, dtype=jnp.float32) / MLA_ROPE))
    ang = positions.astype(jnp.float32)[..., None] * inv
    return jnp.cos(ang), jnp.sin(ang)


def apply_rope(x, cos, sin):
    half = x.shape[-1] // 2
    x1 = x[..., :half].astype(jnp.float32)
    x2 = x[..., half:].astype(jnp.float32)
    return jnp.concatenate([x1 * cos - x2 * sin, x2 * cos + x1 * sin], axis=-1).astype(x.dtype)


def gmlp_spatial_unit(u, v, norm_g, norm_b, ws, bs):
    B, S, _ = u.shape
    nb = S // GMLP_BLOCK
    v = layer_norm(v.reshape(B, S, GMLP_HEADS, GMLP_HEAD_DIM), norm_g, norm_b)
    v = v.reshape(B, nb, GMLP_BLOCK, GMLP_HEADS, GMLP_HEAD_DIM)
    pos_chunk = jnp.arange(GMLP_BLOCK) // CHUNK
    mask = pos_chunk[None, :] <= pos_chunk[:, None]
    w = jnp.where(mask[None], ws, jnp.zeros_like(ws))
    sv = jnp.einsum('hts,bnshd->bnthd', w, v) + bs.T[:, :, None]
    return u * sv.reshape(B, S, GMLP_WIDTH)


def multiscale_pool(xb, pool_w, pool_b, pool_scale):
    B, S, _ = xb.shape
    xg = xb.reshape(B, S, POOL_GROUPS, POOL_GROUP_DIM).astype(jnp.float32)
    cs = jnp.cumsum(xg, axis=1)
    t = jnp.arange(S)
    means = []
    for g, win in enumerate(POOL_WINDOWS):
        csg = cs[:, :, g]
        lagged = jnp.concatenate([jnp.zeros((B, win, POOL_GROUP_DIM), csg.dtype), csg[:, :S - win]], axis=1)
        cnt = jnp.minimum(t + 1, win).astype(jnp.float32)
        means.append((csg - lagged) / cnt[None, :, None])
    pooled = jnp.stack(means, axis=2) - xg
    y = jnp.einsum('bsgd,gde->bsge', pooled.astype(xb.dtype), pool_w).reshape(B, S, POOL_WIDTH)
    return (y + pool_b) * pool_scale


def even_mixer(h, w_in, gmlp_norm_g, gmlp_norm_b, gmlp_ws, gmlp_bs, pool_w, pool_b, pool_scale, w_out):
    proj = h @ w_in
    u, v, z_a, x_b, z_b = jnp.split(proj, [GMLP_WIDTH, 2 * GMLP_WIDTH, 3 * GMLP_WIDTH,
                                           3 * GMLP_WIDTH + POOL_WIDTH], axis=-1)
    a = gmlp_spatial_unit(u, v, gmlp_norm_g, gmlp_norm_b, gmlp_ws, gmlp_bs) * jax.nn.silu(z_a)
    b = multiscale_pool(x_b, pool_w, pool_b, pool_scale) * jax.nn.silu(z_b)
    return jnp.concatenate([a, b], axis=-1) @ w_out


def mla_mixer(h, positions, w_in, q_norm_g, kv_norm_g, w_uq, w_uk, w_uv, w_out):
    B, S, _ = h.shape
    proj = h @ w_in
    q_c, kv_c, k_r, z = jnp.split(proj, [MLA_Q_RANK, MLA_Q_RANK + MLA_KV_RANK,
                                         MLA_Q_RANK + MLA_KV_RANK + MLA_ROPE], axis=-1)
    q_c = rms_norm(q_c, q_norm_g)
    kv_c = rms_norm(kv_c, kv_norm_g)
    q = jnp.einsum('bsr,rhd->bshd', q_c, w_uq)
    q_nope, q_rope = q[..., :MLA_NOPE], q[..., MLA_NOPE:]
    cos, sin = rope_cos_sin(positions)
    q_rope = apply_rope(q_rope, cos[:, :, None, :], sin[:, :, None, :])
    k_rope = apply_rope(k_r, cos, sin)
    q_lat = jnp.einsum('bshd,rhd->bshr', q_nope, w_uk)
    nb = S // Q_BLOCK
    q_lat_b = q_lat.reshape(B, nb, Q_BLOCK, MLA_HEADS, MLA_KV_RANK).transpose(1, 0, 2, 3, 4)
    q_rope_b = q_rope.reshape(B, nb, Q_BLOCK, MLA_HEADS, MLA_ROPE).transpose(1, 0, 2, 3, 4)
    key_chunk = jnp.arange(S) // CHUNK

    def attend_block(args):
        ql, qr, i = args
        s = jnp.einsum('bqhr,bkr->bhqk', ql, kv_c) + jnp.einsum('bqhd,bkd->bhqk', qr, k_rope)
        s = s.astype(jnp.float32) * ATTN_SCALE
        q_chunk = (i * Q_BLOCK + jnp.arange(Q_BLOCK)) // CHUNK
        mask = key_chunk[None, :] <= q_chunk[:, None]
        p = jax.nn.softmax(jnp.where(mask, s, -jnp.inf), axis=-1).astype(kv_c.dtype)
        return jnp.einsum('bhqk,bkr->bqhr', p, kv_c)

    o_lat = lax.map(attend_block, (q_lat_b, q_rope_b, jnp.arange(nb)))
    o_lat = o_lat.transpose(1, 0, 2, 3, 4).reshape(B, S, MLA_HEADS, MLA_KV_RANK)
    o = jnp.einsum('bshr,rhd->bshd', o_lat, w_uv).reshape(B, S, MLA_WIDTH)
    return (o * jax.nn.silu(z)) @ w_out


def setup_inputs(seed: int = 0) -> dict:
    key = jax.random.key(seed)
    ks = jax.random.split(key, 24)
    f32 = jnp.float32

    def nrm(k, shape, s):
        return s * jax.random.normal(k, shape, f32)

    x = nrm(ks[0], (BATCH, SEQ, D_MODEL), 1.0)
    c = nrm(ks[1], (BATCH, D_MODEL), 1.0)
    offs = jax.random.randint(ks[2], (BATCH, 1), 0, 4096, dtype=jnp.int32)
    positions = offs + jnp.arange(SEQ, dtype=jnp.int32)[None, :]
    ada_w = nrm(ks[3], (DEPTH, D_MODEL, 3 * D_MODEL), 0.1 * D_MODEL ** -0.5)
    ada_b = nrm(ks[4], (DEPTH, 3 * D_MODEL), 0.01)
    ln_g = 1.0 + nrm(ks[5], (DEPTH, D_MODEL), 0.02)
    ln_b = nrm(ks[6], (DEPTH, D_MODEL), 0.02)
    e_w_in = nrm(ks[7], (N_EVEN, D_MODEL, EVEN_IN), D_MODEL ** -0.5)
    gmlp_norm_g = 1.0 + nrm(ks[8], (N_EVEN, GMLP_HEAD_DIM), 0.02)
    gmlp_norm_b = nrm(ks[9], (N_EVEN, GMLP_HEAD_DIM), 0.02)
    gmlp_ws = nrm(ks[10], (N_EVEN, GMLP_HEADS, GMLP_BLOCK, GMLP_BLOCK), 0.5 * GMLP_BLOCK ** -0.5)
    gmlp_bs = 1.0 + nrm(ks[11], (N_EVEN, GMLP_HEADS, GMLP_BLOCK), 0.02)
    pool_w = nrm(ks[12], (N_EVEN, POOL_GROUPS, POOL_GROUP_DIM, POOL_GROUP_DIM), POOL_GROUP_DIM ** -0.5)
    pool_b = nrm(ks[13], (N_EVEN, POOL_WIDTH), 0.01)
    pool_scale = 1.0 + nrm(ks[14], (N_EVEN, POOL_WIDTH), 0.1)
    e_w_out = nrm(ks[15], (N_EVEN, EVEN_MIX, D_MODEL), DEEPNORM_BETA * EVEN_MIX ** -0.5)
    o_w_in = nrm(ks[16], (N_ODD, D_MODEL, ODD_IN), D_MODEL ** -0.5)
    mla_q_norm_g = 1.0 + nrm(ks[17], (N_ODD, MLA_Q_RANK), 0.02)
    mla_kv_norm_g = 1.0 + nrm(ks[18], (N_ODD, MLA_KV_RANK), 0.02)
    mla_w_uq = nrm(ks[19], (N_ODD, MLA_Q_RANK, MLA_HEADS, MLA_NOPE + MLA_ROPE), MLA_Q_RANK ** -0.5)
    mla_w_uk = nrm(ks[20], (N_ODD, MLA_KV_RANK, MLA_HEADS, MLA_NOPE), MLA_KV_RANK ** -0.5)
    mla_w_uv = nrm(ks[21], (N_ODD, MLA_KV_RANK, MLA_HEADS, MLA_V), MLA_KV_RANK ** -0.5)
    o_w_out = nrm(ks[22], (N_ODD, MLA_WIDTH, D_MODEL), DEEPNORM_BETA * MLA_WIDTH ** -0.5)
    return {"x": x, "c": c, "positions": positions, "ada_w": ada_w, "ada_b": ada_b,
            "ln_g": ln_g, "ln_b": ln_b, "e_w_in": e_w_in, "gmlp_norm_g": gmlp_norm_g,
            "gmlp_norm_b": gmlp_norm_b, "gmlp_ws": gmlp_ws, "gmlp_bs": gmlp_bs,
            "pool_w": pool_w, "pool_b": pool_b, "pool_scale": pool_scale, "e_w_out": e_w_out,
            "o_w_in": o_w_in, "mla_q_norm_g": mla_q_norm_g, "mla_kv_norm_g": mla_kv_norm_g,
            "mla_w_uq": mla_w_uq, "mla_w_uk": mla_w_uk, "mla_w_uv": mla_w_uv, "o_w_out": o_w_out}


def reference(x, c, positions, ada_w, ada_b, ln_g, ln_b, e_w_in, gmlp_norm_g, gmlp_norm_b,
              gmlp_ws, gmlp_bs, pool_w, pool_b, pool_scale, e_w_out, o_w_in, mla_q_norm_g,
              mla_kv_norm_g, mla_w_uq, mla_w_uk, mla_w_uv, o_w_out):
    cond = jax.nn.silu(c)
    for l in range(DEPTH):
        mod = cond @ ada_w[l] + ada_b[l]
        shift, scale, gate = jnp.split(mod, 3, axis=-1)
        h = x * (1.0 + scale[:, None, :]) + shift[:, None, :]
        if l % 2 == 0:
            e = l // 2
            y = even_mixer(h, e_w_in[e], gmlp_norm_g[e], gmlp_norm_b[e], gmlp_ws[e], gmlp_bs[e],
                           pool_w[e], pool_b[e], pool_scale[e], e_w_out[e])
        else:
            o = l // 2
            y = mla_mixer(h, positions, o_w_in[o], mla_q_norm_g[o], mla_kv_norm_g[o],
                          mla_w_uq[o], mla_w_uk[o], mla_w_uv[o], o_w_out[o])
        x = layer_norm(DEEPNORM_ALPHA * x + (1.0 + gate[:, None, :]) * y, ln_g[l], ln_b[l])
    return x
```

```cpp
#include <hip/hip_runtime.h>
#include <hip/hip_cooperative_groups.h>
#include <cstdio>
namespace cg = cooperative_groups;

#define DI __device__ __forceinline__
typedef unsigned short bf16_t;
typedef short bf16x8 __attribute__((ext_vector_type(8)));
typedef float f32x16 __attribute__((ext_vector_type(16)));
typedef float f32x2 __attribute__((ext_vector_type(2)));
typedef __bf16 bf16x2v __attribute__((ext_vector_type(2)));
#define MFMA(a, b, c) __builtin_amdgcn_mfma_f32_32x32x16_bf16((a), (b), (c), 0, 0, 0)

constexpr int NT = 512;
constexpr int T = 32768, SEQ = 4096;
constexpr float ALPHA = 1.4142135623730951f;
constexpr float QSCALE = 0.07216878364870322f * 1.4426950408889634f;
constexpr size_t MiB = 1024 * 1024;
constexpr size_t OFF_MOD = 0;
constexpr size_t OFF_BAR = 200 * 1024;
constexpr size_t OFF_WSB = 256 * 1024;
constexpr size_t OFF_RSW = 512 * 1024;
constexpr size_t OFF_STATS = 576 * 1024;
constexpr size_t OFF_BT1 = 1 * MiB;
constexpr size_t OFF_BT2 = 11 * MiB;
constexpr size_t OFF_BT3 = 15 * MiB;
constexpr size_t OFF_BT4 = 20 * MiB;
constexpr size_t OFF_BT5 = 22 * MiB;
constexpr size_t OFF_BT6 = 23 * MiB;
constexpr size_t OFF_P0 = 28 * MiB;
constexpr size_t OFF_ZS = 28 * MiB;
constexpr size_t OFF_Q = 156 * MiB;
constexpr size_t OFF_H1 = 156 * MiB;
constexpr size_t OFF_MIX = 348 * MiB;
constexpr size_t OFF_H0 = 348 * MiB;
constexpr size_t OFF_QC = 348 * MiB;
constexpr size_t OFF_KVR = 364 * MiB;
constexpr size_t OFF_QCN = 380 * MiB;
constexpr size_t OFF_COS = 396 * MiB;
constexpr size_t OFF_SIN = 400 * MiB;
constexpr size_t OFF_KB = 476 * MiB;
constexpr size_t OFF_VT = 488 * MiB;
constexpr size_t WS_NEED = 496 * MiB;
constexpr int LDS_BYTES = 147456;

struct Params {
    const float *x, *c; const int* pos;
    const float *ada_w, *ada_b, *ln_g, *ln_b, *e_w_in, *gn_g, *gn_b, *g_ws, *g_bs, *pool_w, *pool_b, *pool_s, *e_w_out;
    const float *o_w_in, *qn_g, *kvn_g, *w_uq, *w_uk, *w_uv, *o_w_out;
    float* out; char* ws;
};

DI unsigned pk2(float a, float b) { f32x2 v = {a, b}; bf16x2v r = __builtin_convertvector(v, bf16x2v); return __builtin_bit_cast(unsigned, r); }
DI int tid_opaque() { int t = threadIdx.x; asm volatile("" : "+v"(t)); return t; }
DI float bf2f(unsigned u16) { return __uint_as_float(u16 << 16); }
DI float bflo(unsigned u) { return __uint_as_float(u << 16); }
DI float bfhi(unsigned u) { return __uint_as_float(u & 0xffff0000u); }
DI float wsum(float v) {
#pragma unroll
    for (int o = 32; o; o >>= 1) v += __shfl_xor(v, o);
    return v;
}
DI float silu(float x) { return x * __builtin_amdgcn_rcpf(1.f + __builtin_amdgcn_exp2f(-1.4426950408889634f * x)); }
typedef short v4i16_t __attribute__((ext_vector_type(4)));
#define LAS __attribute__((address_space(3)))
DI uint2 tr_read(const char* p) { v4i16_t r = __builtin_amdgcn_ds_read_tr16_b64_v4i16((LAS v4i16_t*)p); return __builtin_bit_cast(uint2, r); }
DI unsigned off_b(unsigned row, unsigned ch) { return 256u * row + 16u * (ch ^ (((row & 3u) << 2) | ((row >> 2) & 3u))); }
DI bf16x8 cat8(uint2 lo, uint2 hi) { uint4 u = {lo.x, lo.y, hi.x, hi.y}; return __builtin_bit_cast(bf16x8, u); }
typedef _Float16 f16x2 __attribute__((ext_vector_type(2)));
DI unsigned pkh2(float a, float b) { f32x2 v = {a, b}; f16x2 r = __builtin_convertvector(v, f16x2); return __builtin_bit_cast(unsigned, r); }
DI float hlo(unsigned u) { f16x2 r = __builtin_bit_cast(f16x2, u); return (float)r.x; }
DI float hhi(unsigned u) { f16x2 r = __builtin_bit_cast(f16x2, u); return (float)r.y; }
DI int crow(int i, int h2) { return (i & 3) + 8 * (i >> 2) + 4 * h2; }
DI bf16x8 pack8(float a0, float a1, float a2, float a3, float a4, float a5, float a6, float a7) {
    uint4 u = {pk2(a0, a1), pk2(a2, a3), pk2(a4, a5), pk2(a6, a7)};
    return __builtin_bit_cast(bf16x8, u);
}
DI bf16x8 pack8v(float4 a, float4 b) { return pack8(a.x, a.y, a.z, a.w, b.x, b.y, b.z, b.w); }
DI f32x16 zero16() { f32x16 z;
#pragma unroll
    for (int i = 0; i < 16; ++i) z[i] = 0.f;
    return z; }

namespace pg8 {
#define PG8_LAS __attribute__((address_space(3)))
typedef float f32x4 __attribute__((ext_vector_type(4)));
typedef unsigned u32x4 __attribute__((ext_vector_type(4)));
constexpr int BM = 256, BK = 64, HALF = 128, HTB = HALF * BK * 2, STAGE_BYTES = 8 * HTB, NXCD = 8, WGM = 8;
DI int lds_byte(int r, int c) { const int st = (r >> 4) * 2 + (c >> 5), rr = r & 15, cc = c & 31, ob = rr * 64 + cc * 2; return st * 1024 + (ob ^ (((ob >> 9) & 1) << 5)); }
DI void stage_rc(int b, int& R, int& C) { const int st = b / 1024, sb = b % 1024, swz = sb ^ (((sb >> 9) & 1) << 5); R = (st >> 1) * 16 + swz / 64; C = (st & 1) * 32 + (swz % 64) / 2; }
DI int perm32(int rho) { const int n = rho >> 4, i = rho & 15; return 8 * (i >> 2) + 4 * n + (i & 3); }
struct Unit { int pm, pn; };
struct Gemm { const bf16_t* A; const bf16_t* Bt; int M, N, K; };
struct StaticOrder {
    int nM, nN, nwg, G, c;
    DI void init(int M, int N, int G_, int c_) { nM = M / BM; nN = N / BM; nwg = nM * nN; G = G_; c = c_; }
    DI bool next(int i, Unit& u) const {
        const long L = (long)i * G + c; if (L >= nwg) return false;
        int wgid = (int)L; { const int q = nwg / NXCD, r = nwg % NXCD, xcd = wgid % NXCD, off = wgid / NXCD; wgid = (xcd < r ? xcd * (q + 1) : r * (q + 1) + (xcd - r) * q) + off; }
        const int nig = WGM * nN, gid = wgid / nig, fm = gid * WGM, gsz = (nM - fm) < WGM ? (nM - fm) : WGM;
        u.pm = fm + ((wgid % nig) % gsz); u.pn = (wgid % nig) / gsz; return true;
    }
};
template <class Epi>
DI void gemm_phase(PG8_LAS unsigned char* lds, const Gemm g, const StaticOrder& S, const Epi& E) {
    const int tid = tid_opaque(), wid = __builtin_amdgcn_readfirstlane(tid >> 6), lane = tid & 63, wr = wid >> 2, wc = wid & 3, fr = lane & 15, fq = lane >> 4;
    const int K = g.K, nt = K / BK;
    unsigned voffA[2], voffB[2];
#pragma unroll
    for (int i = 0; i < 2; ++i) { int R, C; stage_rc(tid * 16 + i * 8192, R, C); const int Rb = (R & ~31) + perm32(R & 31);
        voffA[i] = (unsigned)(R * K + C) * 2u; voffB[i] = (unsigned)(Rb * K + C) * 2u; }
    const size_t kstep = (size_t)(BK * 2);
    const size_t hstep = (size_t)HALF * K * 2;
    const size_t tstep = 2 * hstep;
    const unsigned ldsw = (unsigned)wid * 1024u;
    const int aoff = lds_byte(wr * 64 + fr, fq * 8), boff = lds_byte(wc * 32 + fr, fq * 8);
#define PG8_SA(b, h) (((b) * 2 + (h)) * HTB)
#define PG8_SB(b, h) ((4 + (b) * 2 + (h)) * HTB)
#define PG8_STAGE(bufoff, gbase, voff) do { _Pragma("unroll") for (int _i = 0; _i < 2; ++_i) \
        __builtin_amdgcn_global_load_lds((const unsigned*)((const char*)(gbase) + (voff)[_i]), (PG8_LAS unsigned*)(lds + (bufoff) + ldsw + _i * 8192), 16, 0, 0); } while (0)
#define PG8_LDA(dst, b, h) do { _Pragma("unroll") for (int m = 0; m < 4; ++m) _Pragma("unroll") for (int k = 0; k < 2; ++k) dst[m][k] = *(const PG8_LAS bf16x8*)(lds + PG8_SA(b, h) + aoff + m * 2048 + k * 1024); } while (0)
#define PG8_LDB(dst, b, h) do { _Pragma("unroll") for (int n = 0; n < 2; ++n) _Pragma("unroll") for (int k = 0; k < 2; ++k) dst[n][k] = *(const PG8_LAS bf16x8*)(lds + PG8_SB(b, h) + boff + n * 2048 + k * 1024); } while (0)
#define PG8_MMA(ai, bj, At, Bt) do { __builtin_amdgcn_s_setprio(1); _Pragma("unroll") for (int m = 0; m < 4; ++m) _Pragma("unroll") for (int n = 0; n < 2; ++n) _Pragma("unroll") for (int k = 0; k < 2; ++k) \
        acc[ai][bj][m][n] = __builtin_amdgcn_mfma_f32_16x16x32_bf16(Bt[n][k], At[m][k], acc[ai][bj][m][n], 0, 0, 0); __builtin_amdgcn_s_setprio(0); } while (0)
#define PG8_WAIT_V(n) asm volatile("s_waitcnt vmcnt(" #n ")" ::: "memory")
#define PG8_WAIT_L(n) asm volatile("s_waitcnt lgkmcnt(" #n ")" ::: "memory")
#define PG8_BAR __builtin_amdgcn_s_barrier()
#define PG8_SCHED __builtin_amdgcn_sched_barrier(0)
    Unit cur, nxt; int ui = 0;
    if (!S.next(0, cur)) return;
    f32x4 acc[2][2][4][2];
#pragma unroll
    for (int a = 0; a < 2; ++a)
#pragma unroll
        for (int b = 0; b < 2; ++b)
#pragma unroll
            for (int m = 0; m < 4; ++m)
#pragma unroll
                for (int n = 0; n < 2; ++n) acc[a][b][m][n] = (f32x4){0.f, 0.f, 0.f, 0.f};
    bf16x8 At[4][2], B0[2][2], B1[2][2];
    const char* cA = (const char*)g.A + (size_t)cur.pm * tstep; const char* cB = (const char*)g.Bt + (size_t)cur.pn * tstep;
    PG8_STAGE(PG8_SB(0, 0), cB, voffB); PG8_STAGE(PG8_SA(0, 0), cA, voffA); PG8_STAGE(PG8_SB(0, 1), cB + hstep, voffB); PG8_STAGE(PG8_SA(0, 1), cA + hstep, voffA);
    if (wr == 1) PG8_BAR;
    PG8_WAIT_V(4); PG8_BAR;
    PG8_STAGE(PG8_SB(1, 0), cB + kstep, voffB); PG8_STAGE(PG8_SA(1, 0), cA + kstep, voffA); PG8_STAGE(PG8_SB(1, 1), cB + hstep + kstep, voffB);
    PG8_WAIT_V(6); PG8_BAR;
    for (;;) {
        const bool has_next = S.next(ui + 1, nxt);
        const char* nA = has_next ? (const char*)g.A + (size_t)nxt.pm * tstep : cA; const char* nB = has_next ? (const char*)g.Bt + (size_t)nxt.pn * tstep : cB;
        for (int t = 0; t < nt; t += 2) {
            const bool last = (t == nt - 2);
            const char* a1 = cA + (size_t)(t + 1) * kstep;
            const char* a2 = last ? nA : cA + (size_t)(t + 2) * kstep; const char* b2 = last ? nB : cB + (size_t)(t + 2) * kstep;
            const char* a3 = a2 + kstep; const char* b3 = b2 + kstep;
            PG8_LDB(B0, 0, 0); PG8_SCHED; PG8_LDA(At, 0, 0); PG8_STAGE(PG8_SA(1, 1), a1 + hstep, voffA);
            PG8_WAIT_L(8); PG8_BAR; PG8_WAIT_L(0); PG8_MMA(0, 0, At, B0); PG8_BAR; PG8_SCHED;
            PG8_LDB(B1, 0, 1); PG8_STAGE(PG8_SB(0, 0), b2, voffB);
            PG8_BAR; PG8_WAIT_L(0); PG8_MMA(0, 1, At, B1); PG8_BAR;
            PG8_LDA(At, 0, 1); PG8_STAGE(PG8_SA(0, 0), a2, voffA);
            PG8_BAR; PG8_WAIT_L(0); PG8_MMA(1, 0, At, B0); PG8_BAR; PG8_SCHED;
            PG8_STAGE(PG8_SB(0, 1), b2 + hstep, voffB);
            PG8_WAIT_V(6); PG8_BAR; PG8_MMA(1, 1, At, B1); PG8_BAR;
            PG8_LDB(B0, 1, 0); PG8_SCHED; PG8_LDA(At, 1, 0); PG8_STAGE(PG8_SA(0, 1), a2 + hstep, voffA);
            PG8_WAIT_L(8); PG8_BAR; PG8_WAIT_L(0); PG8_MMA(0, 0, At, B0); PG8_BAR; PG8_SCHED;
            PG8_LDB(B1, 1, 1); PG8_STAGE(PG8_SB(1, 0), b3, voffB);
            PG8_BAR; PG8_WAIT_L(0); PG8_MMA(0, 1, At, B1); PG8_BAR;
            PG8_LDA(At, 1, 1); PG8_STAGE(PG8_SA(1, 0), a3, voffA);
            PG8_BAR; PG8_WAIT_L(0); PG8_MMA(1, 0, At, B0); PG8_BAR; PG8_SCHED;
            PG8_STAGE(PG8_SB(1, 1), b3 + hstep, voffB);
            PG8_WAIT_V(6); PG8_BAR; PG8_MMA(1, 1, At, B1); PG8_BAR;
        }
        E(acc, cur, wr, wc, fr, fq);
        if (!has_next) break;
#pragma unroll
        for (int a = 0; a < 2; ++a)
#pragma unroll
            for (int b = 0; b < 2; ++b)
#pragma unroll
                for (int m = 0; m < 4; ++m)
#pragma unroll
                    for (int n = 0; n < 2; ++n) acc[a][b][m][n] = (f32x4){0.f, 0.f, 0.f, 0.f};
        cur = nxt; cA = nA; cB = nB; ++ui;
    }
    PG8_WAIT_V(0);
    if (wr == 0) PG8_BAR;
    PG8_BAR;
#undef PG8_SA
#undef PG8_SB
#undef PG8_STAGE
#undef PG8_LDA
#undef PG8_LDB
#undef PG8_MMA
#undef PG8_WAIT_V
#undef PG8_WAIT_L
#undef PG8_BAR
#undef PG8_SCHED
}
}
using pg8::f32x4;
typedef const f32x4 (&AccRef)[2][2][4][2];

DI uint4 pack8q(f32x4 a, f32x4 b) { uint4 u = {pk2(a[0], a[1]), pk2(a[2], a[3]), pk2(b[0], b[1]), pk2(b[2], b[3])}; return u; }
DI f32x4 silu4(f32x4 v) { f32x4 r = {silu(v[0]), silu(v[1]), silu(v[2]), silu(v[3])}; return r; }
struct Epi1 {
    bf16_t* proj;
    DI void operator()(AccRef acc, const pg8::Unit& u, int wr_, int wc_, int fr_, int fq_) const {
        const int t_ = tid_opaque(), wid_ = __builtin_amdgcn_readfirstlane(t_ >> 6), wr = wid_ >> 2, wc = wid_ & 3, fr = t_ & 15, fq = (t_ >> 4) & 3;
        const bool act = (u.pn >= 8 && u.pn < 12) || u.pn >= 16;
        bf16_t* p0 = proj + (size_t)(u.pm * 256 + wr * 64 + fr) * 5120 + u.pn * 256 + wc * 32 + 8 * fq;
#pragma unroll
        for (int ai = 0; ai < 2; ++ai)
#pragma unroll
            for (int m = 0; m < 4; ++m)
#pragma unroll
                for (int bj = 0; bj < 2; ++bj) {
                    f32x4 v0 = acc[ai][bj][m][0], v1 = acc[ai][bj][m][1];
                    if (act) { v0 = silu4(v0); v1 = silu4(v1); }
                    *(uint4*)(p0 + (size_t)(ai * 128 + m * 16) * 5120 + bj * 128) = pack8q(v0, v1);
                }
    }
};
struct EpiRes {
    const float* xin; float* out; const float* gate;
    DI void operator()(AccRef acc, const pg8::Unit& u, int wr_, int wc_, int fr_, int fq_) const {
        const int t_ = tid_opaque(), wid_ = __builtin_amdgcn_readfirstlane(t_ >> 6), wr = wid_ >> 2, wc = wid_ & 3, fr = t_ & 15, fq = (t_ >> 4) & 3;
        const int row0 = u.pm * 256 + wr * 64 + fr, col0 = u.pn * 256 + wc * 32 + 8 * fq, b = row0 >> 12;
        f32x4 gv[2][2];
#pragma unroll
        for (int bj = 0; bj < 2; ++bj) { gv[bj][0] = *(const f32x4*)(gate + b * 3072 + col0 + bj * 128) + 1.f; gv[bj][1] = *(const f32x4*)(gate + b * 3072 + col0 + bj * 128 + 4) + 1.f; }
        const float* xp = xin + (size_t)row0 * 1024 + col0;
        f32x4 c0 = *(const f32x4*)xp, c1 = *(const f32x4*)(xp + 4), c2 = *(const f32x4*)(xp + 128), c3 = *(const f32x4*)(xp + 132);
#pragma unroll
        for (int it = 0; it < 8; ++it) {
            const int ai = it >> 2, m = it & 3;
            const size_t off = (size_t)(row0 + ai * 128 + m * 16) * 1024 + col0;
            f32x4 n0 = c0, n1 = c1, n2 = c2, n3 = c3;
            if (it + 1 < 8) {
                const float* np = xin + (size_t)(row0 + ((it + 1) >> 2) * 128 + ((it + 1) & 3) * 16) * 1024 + col0;
                n0 = *(const f32x4*)np; n1 = *(const f32x4*)(np + 4); n2 = *(const f32x4*)(np + 128); n3 = *(const f32x4*)(np + 132);
            }
            asm volatile("" ::: "memory");
            *(f32x4*)(out + off) = c0 * ALPHA + gv[0][0] * acc[ai][0][m][0];
            *(f32x4*)(out + off + 4) = c1 * ALPHA + gv[0][1] * acc[ai][0][m][1];
            *(f32x4*)(out + off + 128) = c2 * ALPHA + gv[1][0] * acc[ai][1][m][0];
            *(f32x4*)(out + off + 132) = c3 * ALPHA + gv[1][1] * acc[ai][1][m][1];
            c0 = n0; c1 = n1; c2 = n2; c3 = n3;
        }
    }
};
struct EpiResLn {
    static constexpr bool AFTER_DRAIN = false;
    float* io; const float2* stats; const float *lng, *lnb, *gate;
    DI void operator()(AccRef acc, const pg8::Unit& u, int wr_, int wc_, int fr_, int fq_) const {
        const int t_ = tid_opaque(), wid_ = __builtin_amdgcn_readfirstlane(t_ >> 6), wr = wid_ >> 2, wc = wid_ & 3, fr = t_ & 15, fq = (t_ >> 4) & 3;
        const int row0 = u.pm * 256 + wr * 64 + fr, col0 = u.pn * 256 + wc * 32 + 8 * fq, b = row0 >> 12;
        f32x4 gv[2][2], lg[2][2], lb[2][2];
#pragma unroll
        for (int bj = 0; bj < 2; ++bj)
#pragma unroll
            for (int n = 0; n < 2; ++n) {
                const int col = col0 + bj * 128 + 4 * n;
                gv[bj][n] = *(const f32x4*)(gate + b * 3072 + col) + 1.f; lg[bj][n] = *(const f32x4*)(lng + col) * ALPHA; lb[bj][n] = *(const f32x4*)(lnb + col) * ALPHA;
            }
        float2 st = stats[row0];
        f32x4 r0 = *(const f32x4*)(io + (size_t)row0 * 1024 + col0), r1 = *(const f32x4*)(io + (size_t)row0 * 1024 + col0 + 4);
#pragma unroll
        for (int it = 0; it < 16; ++it) {
            const int bj = it >> 3, ai = (it >> 2) & 1, m = it & 3;
            float* pp = io + (size_t)(row0 + ai * 128 + m * 16) * 1024 + col0 + bj * 128;
            float2 nst = st; f32x4 n0 = r0, n1 = r1;
            if (it + 1 < 16) {
                const int nb = (it + 1) >> 3, nrow = row0 + (((it + 1) >> 2) & 1) * 128 + ((it + 1) & 3) * 16;
                nst = stats[nrow]; n0 = *(const f32x4*)(io + (size_t)nrow * 1024 + col0 + nb * 128); n1 = *(const f32x4*)(io + (size_t)nrow * 1024 + col0 + nb * 128 + 4);
            }
            asm volatile("" ::: "memory");
            *(f32x4*)pp = (r0 - st.x) * st.y * lg[bj][0] + lb[bj][0] + gv[bj][0] * acc[ai][bj][m][0];
            *(f32x4*)(pp + 4) = (r1 - st.x) * st.y * lg[bj][1] + lb[bj][1] + gv[bj][1] * acc[ai][bj][m][1];
            st = nst; r0 = n0; r1 = n1;
        }
    }
};
struct Epi3 {
    bf16_t *zs, *qc, *kvr;
    DI void operator()(AccRef acc, const pg8::Unit& u, int wr_, int wc_, int fr_, int fq_) const {
        const int t_ = tid_opaque(), wid_ = __builtin_amdgcn_readfirstlane(t_ >> 6), wr = wid_ >> 2, wc = wid_ & 3, fr = t_ & 15, fq = (t_ >> 4) & 3;
        const int row0 = u.pm * 256 + wr * 64 + fr, cw = wc * 32 + 8 * fq;
        bf16_t* p0; int ld; size_t bjs = 128;
        if (u.pn < 8) { bjs = (size_t)SEQ * 128; p0 = zs + ((size_t)((row0 >> 12) * 16 + 2 * u.pn) * SEQ + (row0 & (SEQ - 1))) * 128 + cw; ld = 128; }
        else if (u.pn == 8) { p0 = qc + (size_t)row0 * 256 + cw; ld = 256; }
        else { p0 = kvr + (size_t)row0 * 256 + cw; ld = 256; }
        const bool act = u.pn < 8;
#pragma unroll
        for (int ai = 0; ai < 2; ++ai)
#pragma unroll
            for (int m = 0; m < 4; ++m)
#pragma unroll
                for (int bj = 0; bj < 2; ++bj) {
                    f32x4 v0 = acc[ai][bj][m][0], v1 = acc[ai][bj][m][1];
                    if (act) { v0 = silu4(v0); v1 = silu4(v1); }
                    *(uint4*)(p0 + (size_t)(ai * 128 + m * 16) * ld + bj * bjs) = pack8q(v0, v1);
                }
    }
};
DI size_t qfo(int row, int hh, int d) { return ((size_t)(((row >> 12) * 16 + hh) * 128 + ((row & (SEQ - 1)) >> 5)) * 6144) + (size_t)((d >> 3) * 256 + (row & 31) * 8); }
struct Epi4 {
    bf16_t* Q; const float *cosT, *sinT;
    DI void operator()(AccRef acc, const pg8::Unit& u, int wr_, int wc_, int fr_, int fq_) const {
        const int t_ = tid_opaque(), wid_ = __builtin_amdgcn_readfirstlane(t_ >> 6), wr = wid_ >> 2, wc = wid_ & 3, fr = t_ & 15, fq = (t_ >> 4) & 3;
        const int row0 = u.pm * 256 + wr * 64 + fr;
        if (u.pn < 8) {
#pragma unroll
            for (int ai = 0; ai < 2; ++ai)
#pragma unroll
                for (int m = 0; m < 4; ++m)
#pragma unroll
                    for (int bj = 0; bj < 2; ++bj) {
                        const int hh = 2 * u.pn + bj;
                        *(uint4*)(Q + qfo(row0 + ai * 128 + m * 16, hh, wc * 32 + 8 * fq)) = pack8q(acc[ai][bj][m][0] * QSCALE, acc[ai][bj][m][1] * QSCALE);
                    }
        } else {
            const int i0 = 4 * ((wc & 1) * 4 + fq);
            f32x4 cv8[8], sv8[8];
#pragma unroll
            for (int it = 0; it < 8; ++it) {
                const int row = row0 + (it >> 2) * 128 + (it & 3) * 16;
                cv8[it] = *(const f32x4*)(cosT + (size_t)row * 32 + i0); sv8[it] = *(const f32x4*)(sinT + (size_t)row * 32 + i0);
            }
#pragma unroll
            for (int it = 0; it < 8; ++it) {
                const int ai = it >> 2, m = it & 3;
                const int row = row0 + ai * 128 + m * 16;
                const f32x4 cv = cv8[it] * QSCALE, sv = sv8[it] * QSCALE;
#pragma unroll
                for (int bj = 0; bj < 2; ++bj) {
                    const int hh = (u.pn - 8) * 4 + bj * 2 + (wc >> 1);
                    const f32x4 x1 = acc[ai][bj][m][0], x2 = acc[ai][bj][m][1];
                    const f32x4 o1 = x1 * cv - x2 * sv, o2 = x2 * cv + x1 * sv;
                    bf16_t* qp = Q + qfo(row, hh, (128 + i0) & ~7) + (i0 & 7);
                    uint2 w1 = {pk2(o1[0], o1[1]), pk2(o1[2], o1[3])}, w2 = {pk2(o2[0], o2[1]), pk2(o2[2], o2[3])};
                    *(uint2*)qp = w1; *(uint2*)(qp + 1024) = w2;
                }
            }
        }
    }
};

DI void transpose_tile_wave(const float* __restrict__ src, int ld, int K, int kt, int c0, bf16_t* __restrict__ dst, int r0, bool ropeperm, bool kperm, float* tl, int lane) {
    float4 v[16];
#pragma unroll
    for (int i = 0; i < 16; ++i) { const int idx = lane + 64 * i, kr = idx >> 4, c4 = idx & 15; v[i] = *(const float4*)(src + (size_t)(kt * 64 + kr) * ld + c0 + 4 * c4); }
#pragma unroll
    for (int i = 0; i < 16; ++i) { const int idx = lane + 64 * i, kr = idx >> 4, c4 = idx & 15; float* d = tl + kr * 65 + 4 * c4; d[0] = v[i].x; d[1] = v[i].y; d[2] = v[i].z; d[3] = v[i].w; }
    const int n = lane;
    const int nd = ropeperm ? (8 * ((n & 31) >> 2) + 4 * (n >> 5) + (n & 3)) : n;
    bf16_t* dp = dst + (size_t)(r0 + nd) * K + kt * 64;
#pragma unroll
    for (int k8 = 0; k8 < 8; ++k8) {
        const float* s = tl + (k8 * 8) * 65 + n;
        uint4 o = {pk2(s[0], s[65]), pk2(s[130], s[195]), pk2(s[260], s[325]), pk2(s[390], s[455])};
        if (!kperm) *(uint4*)(dp + k8 * 8) = o;
        else {
            const int gn = r0 + n, hh_ = gn >> 7, dd = gn & 127, x = dd & 31;
            const int m_ = (((x >> 3) & 1) << 4) | (((x >> 2) & 1) << 3) | ((x >> 4) << 2) | (x & 3);
            const int ks_ = kt * 4 + (k8 >> 1);
            bf16_t* d2 = dst + ((size_t)(((hh_ * 4 + (dd >> 5)) * 8 + ks_) * 2) * 32 + m_) * 8 + (k8 & 1) * 4;
            *(uint2*)d2 = make_uint2(o.x, o.y); *(uint2*)(d2 + 256) = make_uint2(o.z, o.w);
        }
    }
}

DI void phase0(const Params& p, char* smem) {
    const int tid = tid_opaque(), lane = tid & 63, w = tid >> 6, l31 = lane & 31, h2 = lane >> 5;
    float* mod = (float*)(p.ws + OFF_MOD);
    bf16_t* Bt1 = (bf16_t*)(p.ws + OFF_BT1); bf16_t* Bt2 = (bf16_t*)(p.ws + OFF_BT2); bf16_t* Bt3 = (bf16_t*)(p.ws + OFF_BT3);
    bf16_t* Bt4 = (bf16_t*)(p.ws + OFF_BT4); bf16_t* Bt5 = (bf16_t*)(p.ws + OFF_BT5); bf16_t* Bt6 = (bf16_t*)(p.ws + OFF_BT6);
    bf16_t* Wsb = (bf16_t*)(p.ws + OFF_WSB);
    constexpr int N_ADA = 192, N_TR = 2800, N_FA = 64, N_FB = 128, N_MISC = 65;
    constexpr int TOTAL = N_ADA + N_FA + N_FB + N_MISC;
    for (int it = blockIdx.x; it < TOTAL; it += gridDim.x) {
        if (it < N_ADA) {
            const int l = it / 96, cb = it % 96;
            float* sc = (float*)smem;
            const int kg = tid >> 5, cl = tid & 31, col = cb * 32 + cl;
            const float* wp = p.ada_w + ((size_t)l * 1024 + kg * 64) * 3072 + col;
            float wv[64];
#pragma unroll
            for (int k = 0; k < 64; ++k) wv[k] = wp[(size_t)k * 3072];
#pragma unroll
            for (int i = 0; i < 16; ++i) { const int idx = tid + 512 * i; sc[idx] = silu(p.c[idx]); }
            __syncthreads();
            float a[8];
#pragma unroll
            for (int b = 0; b < 8; ++b) a[b] = 0.f;
#pragma unroll
            for (int k = 0; k < 64; ++k) {
#pragma unroll
                for (int b = 0; b < 8; ++b) a[b] += sc[b * 1024 + kg * 64 + k] * wv[k];
            }
            float* red = sc + 8192;
#pragma unroll
            for (int b = 0; b < 8; ++b) red[(kg * 8 + b) * 32 + cl] = a[b];
            __syncthreads();
            if (tid < 256) {
                const int b = tid >> 5;
                float s = p.ada_b[l * 3072 + col];
#pragma unroll
                for (int g = 0; g < 16; ++g) s += red[(g * 8 + b) * 32 + cl];
                mod[(l * 8 + b) * 3072 + col] = s;
            }
            __syncthreads();
        } else if (it < N_ADA + N_FA) {
            const int wt = (it - N_ADA) * 8 + w, hh = wt >> 5, rt = (wt >> 3) & 3, kt = wt & 7;
            f32x16 acc = zero16();
            const float* ap = p.w_uk + ((size_t)(rt * 32 + l31) * 16 + hh) * 128 + 8 * h2;
            const float* bp = p.w_uq + ((size_t)(kt * 32 + l31) * 16 + hh) * 192 + 8 * h2;
#pragma unroll
            for (int s = 0; s < 8; ++s) {
                const bf16x8 af = pack8v(*(const float4*)(ap + 16 * s), *(const float4*)(ap + 16 * s + 4));
                const bf16x8 bf = pack8v(*(const float4*)(bp + 16 * s), *(const float4*)(bp + 16 * s + 4));
                acc = MFMA(af, bf, acc);
            }
#pragma unroll
            for (int i = 0; i < 16; ++i) Bt4[(size_t)(hh * 128 + rt * 32 + crow(i, h2)) * 256 + kt * 32 + l31] = (bf16_t)(pk2(acc[i], 0.f) & 0xffffu);
        } else if (it < N_ADA + N_FA + N_FB) {
            const int wt = (it - N_ADA - N_FA) * 8 + w, g = wt >> 8, et = (wt >> 5) & 7, kt = wt & 31;
            f32x16 acc = zero16();
            const float* ap = p.pool_w + ((size_t)g * 256 + 8 * h2) * 256 + et * 32 + l31;
            const float* bp = p.e_w_in + (size_t)(kt * 32 + l31) * 5120 + 3072 + g * 256 + 8 * h2;
#pragma unroll 4
            for (int s = 0; s < 16; ++s) {
                const float* a = ap + (size_t)(16 * s) * 256;
                const bf16x8 af = pack8(a[0], a[256], a[512], a[768], a[1024], a[1280], a[1536], a[1792]);
                const bf16x8 bf = pack8v(*(const float4*)(bp + 16 * s), *(const float4*)(bp + 16 * s + 4));
                acc = MFMA(af, bf, acc);
            }
#pragma unroll
            for (int i = 0; i < 16; ++i) Bt1[(size_t)(3072 + g * 256 + et * 32 + crow(i, h2)) * 1024 + kt * 32 + l31] = (bf16_t)(pk2(acc[i], 0.f) & 0xffffu);
        } else {
            const int m = it - (N_ADA + N_FA + N_FB);
            if (m == 0) {
                uint4 z = {0u, 0u, 0u, 0u};
                uint4* d = (uint4*)(Bt3 + (size_t)2496 * 1024);
                for (int i = tid; i < 64 * 1024 / 8; i += NT) d[i] = z;
            } else {
                const int row = (m - 1) * 8 + w, t = row & 127;
                const float2 v = *(const float2*)(p.g_ws + (size_t)row * 128 + 2 * lane);
                const bool keep = (lane >> 5) <= (t >> 6);
                const unsigned u = keep ? pk2(v.x, v.y) : 0u;
                *(unsigned*)(Wsb + ((size_t)((((row >> 7) * 4 + (t >> 5)) * 8 + (lane >> 3)) * 2 + ((lane >> 2) & 1))) * 256 + (t & 31) * 8 + 2 * (lane & 3)) = u;
                const float sum = wsum(bflo(u) + bfhi(u));
                if (lane == 0) ((float*)(p.ws + OFF_RSW))[row] = sum;
            }
        }
    }
    __syncthreads();
    {
        float* tlw = (float*)smem + w * (64 * 65);
        const int gw = (int)gridDim.x * 8 - 1 - ((int)blockIdx.x * 8 + w);
        for (int tt = gw; tt < N_TR; tt += (int)gridDim.x * 8) {
            int t = tt;
            const float* src; int ld, K, c0, r0, kt; bf16_t* dst; bool rp = false, kp = false;
            if (t < 768) { src = p.e_w_in; ld = 5120; K = 1024; const int nt = t % 48; kt = t / 48; c0 = nt * 64; r0 = c0; dst = Bt1; }
            else if ((t -= 768) < 256) { src = p.e_w_in; ld = 5120; K = 1024; const int nt = t % 16; kt = t / 16; c0 = 4096 + nt * 64; r0 = c0; dst = Bt1; }
            else if ((t -= 256) < 512) { src = p.e_w_out; ld = 1024; K = 2048; const int nt = t % 16; kt = t / 16; c0 = nt * 64; r0 = c0; dst = Bt2; }
            else if ((t -= 512) < 512) { src = p.o_w_in; ld = 2496; K = 1024; const int nt = t % 32; kt = t / 32; c0 = 448 + nt * 64; r0 = nt * 64; dst = Bt3; }
            else if ((t -= 512) < 112) { src = p.o_w_in; ld = 2496; K = 1024; const int nt = t % 7; kt = t / 7; c0 = nt * 64; r0 = 2048 + nt * 64; dst = Bt3; }
            else if ((t -= 112) < 64) { src = p.w_uq; ld = 3072; K = 256; const int hh = t % 16; kt = t / 16; c0 = hh * 192 + 128; r0 = 2048 + hh * 64; dst = Bt4; rp = true; }
            else if ((t -= 64) < 64) { src = p.w_uv; ld = 2048; K = 128; const int nt = t % 32; kt = t / 32; c0 = nt * 64; r0 = c0; dst = Bt5; kp = true; }
            else { t -= 64; src = p.o_w_out; ld = 1024; K = 2048; const int nt = t % 16; kt = t / 16; c0 = nt * 64; r0 = c0; dst = Bt6; }
            transpose_tile_wave(src, ld, K, kt, c0, dst, r0, rp, kp, tlw, lane);
        }
    }
}

DI void phase1(const Params& p) {
    const float* mod = (const float*)(p.ws + OFF_MOD);
    bf16_t* h0 = (bf16_t*)(p.ws + OFF_H0);
    const int tid = tid_opaque();
    const size_t total = (size_t)T * 128, stride = (size_t)gridDim.x * NT;
    for (size_t base = (size_t)blockIdx.x * NT + tid; base < total; base += 4 * stride) {
        float4 xa[4], xb[4];
#pragma unroll
        for (int k = 0; k < 4; ++k) {
            const size_t idx = base + k * stride;
            if (idx < total) { const float* xp = p.x + idx * 8; const f32x4 a_ = __builtin_nontemporal_load((const f32x4*)xp), b_ = __builtin_nontemporal_load((const f32x4*)(xp + 4)); xa[k] = make_float4(a_[0], a_[1], a_[2], a_[3]); xb[k] = make_float4(b_[0], b_[1], b_[2], b_[3]); }
        }
#pragma unroll
        for (int k = 0; k < 4; ++k) {
            const size_t idx = base + k * stride;
            if (idx < total) {
                const int row = (int)(idx >> 7), col = ((int)idx & 127) * 8, b = row >> 12;
                const float* mp = mod + b * 3072 + col;
                const float4 sh0 = *(const float4*)mp, sh1 = *(const float4*)(mp + 4), sc0 = *(const float4*)(mp + 1024), sc1 = *(const float4*)(mp + 1028);
                const float4 x0 = xa[k], x1 = xb[k];
                uint4 o = {pk2(x0.x * (1.f + sc0.x) + sh0.x, x0.y * (1.f + sc0.y) + sh0.y), pk2(x0.z * (1.f + sc0.z) + sh0.z, x0.w * (1.f + sc0.w) + sh0.w),
                           pk2(x1.x * (1.f + sc1.x) + sh1.x, x1.y * (1.f + sc1.y) + sh1.y), pk2(x1.z * (1.f + sc1.z) + sh1.z, x1.w * (1.f + sc1.w) + sh1.w)};
                *(uint4*)(h0 + idx * 8) = o;
            }
        }
    }
}

template <int WIN>
DI void pool_rows(const bf16_t* __restrict__ proj, bf16_t* __restrict__ mix, const float* __restrict__ pool_b, const float* __restrict__ pool_s, int t0, int c0) {
    const int s0 = t0 & (SEQ - 1);
    const bf16_t* xp = proj + (size_t)t0 * 5120 + 3072 + c0;
    uint4 xr[WIN + 7], zr[8];
#pragma unroll
    for (int k = 0; k < WIN + 7; ++k) {
        const int dr = k - (WIN - 1);
        uint4 v = {0u, 0u, 0u, 0u};
        if (s0 + dr >= 0) v = *(const uint4*)(xp + (ptrdiff_t)dr * 5120);
        xr[k] = v;
    }
#pragma unroll
    for (int i = 0; i < 8; ++i) zr[i] = *(const uint4*)(xp + (size_t)i * 5120 + 1024);
    const float4 pb0 = *(const float4*)(pool_b + c0), pb1 = *(const float4*)(pool_b + c0 + 4);
    const float4 ps0 = *(const float4*)(pool_s + c0), ps1 = *(const float4*)(pool_s + c0 + 4);
    float a0 = 0.f, a1 = 0.f, a2 = 0.f, a3 = 0.f, a4 = 0.f, a5 = 0.f, a6 = 0.f, a7 = 0.f;
#pragma unroll
    for (int k = 0; k < WIN - 1; ++k) {
        const uint4 v = xr[k];
        a0 += bflo(v.x); a1 += bfhi(v.x); a2 += bflo(v.y); a3 += bfhi(v.y); a4 += bflo(v.z); a5 += bfhi(v.z); a6 += bflo(v.w); a7 += bfhi(v.w);
    }
#pragma unroll
    for (int i = 0; i < 8; ++i) {
        const uint4 xv = xr[WIN - 1 + i], zv = zr[i];
        a0 += bflo(xv.x); a1 += bfhi(xv.x); a2 += bflo(xv.y); a3 += bfhi(xv.y); a4 += bflo(xv.z); a5 += bfhi(xv.z); a6 += bflo(xv.w); a7 += bfhi(xv.w);
        const int cnt = min(s0 + i + 1, WIN);
        const float ic = 1.f / (float)cnt;
        const float o0 = ((a0 * ic - bflo(xv.x)) + pb0.x) * ps0.x * bflo(zv.x);
        const float o1 = ((a1 * ic - bfhi(xv.x)) + pb0.y) * ps0.y * bfhi(zv.x);
        const float o2 = ((a2 * ic - bflo(xv.y)) + pb0.z) * ps0.z * bflo(zv.y);
        const float o3 = ((a3 * ic - bfhi(xv.y)) + pb0.w) * ps0.w * bfhi(zv.y);
        const float o4 = ((a4 * ic - bflo(xv.z)) + pb1.x) * ps1.x * bflo(zv.z);
        const float o5 = ((a5 * ic - bfhi(xv.z)) + pb1.y) * ps1.y * bfhi(zv.z);
        const float o6 = ((a6 * ic - bflo(xv.w)) + pb1.z) * ps1.z * bflo(zv.w);
        const float o7 = ((a7 * ic - bfhi(xv.w)) + pb1.w) * ps1.w * bfhi(zv.w);
        uint4 o = {pk2(o0, o1), pk2(o2, o3), pk2(o4, o5), pk2(o6, o7)};
        *(uint4*)(mix + (size_t)(t0 + i) * 2048 + 1024 + c0) = o;
        const uint4 lv = xr[i];
        a0 -= bflo(lv.x); a1 -= bfhi(lv.x); a2 -= bflo(lv.y); a3 -= bfhi(lv.y); a4 -= bflo(lv.z); a5 -= bfhi(lv.z); a6 -= bflo(lv.w); a7 -= bfhi(lv.w);
    }
}

DI void phase3(const Params& p, char* smem, int it_lo, int it_hi) {
    const int tid = tid_opaque(), lane = tid & 63, w = tid >> 6, l31 = lane & 31, h2 = lane >> 5;
    const bf16_t* proj = (const bf16_t*)(p.ws + OFF_P0);
    bf16_t* mix = (bf16_t*)(p.ws + OFF_MIX);
    const bf16_t* Wsb = (const bf16_t*)(p.ws + OFF_WSB);
    const float* rsw = (const float*)(p.ws + OFF_RSW);
    const unsigned q4 = (lane & 15) >> 2, pp = lane & 3, lo = 2 * ((lane >> 4) & 1) + (pp >> 1);
    for (int it = it_lo + blockIdx.x; it < it_hi; it += gridDim.x) {
        if (it < 1024) {
            const int head = it & 3, nb = (it >> 2) & 31, b = it >> 7;
            const int t0 = b * SEQ + nb * 128;
            const int wt = w & 3, wd = w >> 2;
            bf16x8 wf[8];
            {
                const bf16_t* wp = Wsb + ((size_t)((head * 4 + wt) * 8) * 2 + h2) * 256 + l31 * 8;
#pragma unroll
                for (int kk = 0; kk < 8; ++kk) wf[kk] = *(const bf16x8*)(wp + 512 * kk);
            }
            const int crow_ = tid >> 5, cch = tid & 31;
            {
                const bf16_t* vp = proj + (size_t)(t0 + crow_) * 5120 + 1024 + head * 256 + cch * 8;
                uint4 rv[8];
#pragma unroll
                for (int i = 0; i < 8; ++i) rv[i] = *(const uint4*)(vp + (size_t)(16 * i) * 5120);
#pragma unroll
                for (int i = 0; i < 8; ++i) { const int row = 16 * i + crow_; *(uint4*)(smem + (row >> 5) * 16384 + (cch >> 4) * 8192 + off_b(row & 31, cch & 15)) = rv[i]; }
            }
            uint4 ur[8];
            {
                const bf16_t* up = proj + (size_t)(t0 + crow_) * 5120 + head * 256 + cch * 8;
#pragma unroll
                for (int i = 0; i < 8; ++i) ur[i] = *(const uint4*)(up + (size_t)(16 * i) * 5120);
            }
            __syncthreads();
            {
                const int row = tid >> 2, qd = tid & 3;
                char* ib = smem + (row >> 5) * 16384 + (qd >> 1) * 8192;
                uint4 rv[8];
#pragma unroll
                for (int i = 0; i < 8; ++i) rv[i] = *(const uint4*)(ib + off_b(row & 31, (qd & 1) * 8 + i));
                float sm = 0.f, sq = 0.f;
#pragma unroll
                for (int i = 0; i < 8; ++i) {
                    const float f0 = bflo(rv[i].x), f1 = bfhi(rv[i].x), f2 = bflo(rv[i].y), f3 = bfhi(rv[i].y), f4 = bflo(rv[i].z), f5 = bfhi(rv[i].z), f6 = bflo(rv[i].w), f7 = bfhi(rv[i].w);
                    sm += ((f0 + f1) + (f2 + f3)) + ((f4 + f5) + (f6 + f7));
                    sq += ((f0 * f0 + f1 * f1) + (f2 * f2 + f3 * f3)) + ((f4 * f4 + f5 * f5) + (f6 * f6 + f7 * f7));
                }
                sm += __shfl_xor(sm, 1); sq += __shfl_xor(sq, 1);
                sm += __shfl_xor(sm, 2); sq += __shfl_xor(sq, 2);
                const float mu = sm * (1.f / 256.f);
                const float rstd = rsqrtf(fmaxf(sq * (1.f / 256.f) - mu * mu, 0.f) + 1e-5f);
                const float nb_ = -mu * rstd;
#pragma unroll
                for (int i = 0; i < 8; ++i) {
                    uint4 o = {pk2(bflo(rv[i].x) * rstd + nb_, bfhi(rv[i].x) * rstd + nb_), pk2(bflo(rv[i].y) * rstd + nb_, bfhi(rv[i].y) * rstd + nb_),
                               pk2(bflo(rv[i].z) * rstd + nb_, bfhi(rv[i].z) * rstd + nb_), pk2(bflo(rv[i].w) * rstd + nb_, bfhi(rv[i].w) * rstd + nb_)};
                    *(uint4*)(ib + off_b(row & 31, (qd & 1) * 8 + i)) = o;
                }
            }
            __syncthreads();
            uint4 zr[8];
            {
                const bf16_t* up = proj + (size_t)(t0 + crow_) * 5120 + head * 256 + cch * 8;
#pragma unroll
                for (int i = 0; i < 8; ++i) zr[i] = *(const uint4*)(up + (size_t)(16 * i) * 5120 + 2048);
            }
            char* SV = smem + 65536;
            {
                f32x16 acc[4];
#pragma unroll
                for (int c = 0; c < 4; ++c) acc[c] = zero16();
                const int nks = wt < 2 ? 4 : 8;
                const char* vb = smem + wd * 8192 + 2048 * h2 + 256 * q4 + 8 * (pp & 1);
#pragma unroll
                for (int kk = 0; kk < 8; ++kk) {
                    if (kk < nks) {
                        const char* kb = vb + (kk >> 1) * 16384 + (kk & 1) * 4096;
#pragma unroll
                        for (int c = 0; c < 4; ++c) {
                            const uint2 t0v = tr_read(kb + 64 * (c ^ q4) + 16 * (lo ^ (2 * h2)));
                            const uint2 t1v = tr_read(kb + 1024 + 64 * (c ^ q4) + 16 * (lo ^ (2 * h2 + 1)));
                            acc[c] = MFMA(cat8(t0v, t1v), wf[kk], acc[c]);
                        }
                    }
                }
                const int tl = wt * 32 + l31;
                const float rs = rsw[head * 128 + tl];
                const float* gp = p.gn_g + wd * 128 + 4 * h2;
                const float* bp = p.gn_b + wd * 128 + 4 * h2;
                char* sp = SV + tl * 528 + (wd * 128 + 4 * h2) * 2;
#pragma unroll
                for (int dt = 0; dt < 4; ++dt)
#pragma unroll
                    for (int g = 0; g < 4; ++g) {
                        const float4 gg = *(const float4*)(gp + dt * 32 + 8 * g), gb = *(const float4*)(bp + dt * 32 + 8 * g);
                        uint2 o = {pkh2(gg.x * acc[dt][4 * g] + gb.x * rs, gg.y * acc[dt][4 * g + 1] + gb.y * rs),
                                   pkh2(gg.z * acc[dt][4 * g + 2] + gb.z * rs, gg.w * acc[dt][4 * g + 3] + gb.w * rs)};
                        *(uint2*)(sp + (dt * 32 + 8 * g) * 2) = o;
                    }
            }
            __syncthreads();
            {
                bf16_t* op = mix + (size_t)(t0 + crow_) * 2048 + head * 256 + cch * 8;
#pragma unroll
                for (int i = 0; i < 8; ++i) {
                    const int row = 16 * i + crow_;
                    const float bsv = p.g_bs[head * 128 + row];
                    const uint4 sv = *(const uint4*)(SV + row * 528 + cch * 16);
                    const uint4 uv = ur[i], zv = zr[i];
                    uint4 o = {pk2(bflo(uv.x) * (hlo(sv.x) + bsv) * bflo(zv.x), bfhi(uv.x) * (hhi(sv.x) + bsv) * bfhi(zv.x)),
                               pk2(bflo(uv.y) * (hlo(sv.y) + bsv) * bflo(zv.y), bfhi(uv.y) * (hhi(sv.y) + bsv) * bfhi(zv.y)),
                               pk2(bflo(uv.z) * (hlo(sv.z) + bsv) * bflo(zv.z), bfhi(uv.z) * (hhi(sv.z) + bsv) * bfhi(zv.z)),
                               pk2(bflo(uv.w) * (hlo(sv.w) + bsv) * bflo(zv.w), bfhi(uv.w) * (hhi(sv.w) + bsv) * bfhi(zv.w))};
                    *(uint4*)(op + (size_t)(16 * i) * 2048) = o;
                }
            }
        } else {
            const int rb = it - 1024;
            const int grp = w & 3, c0 = (grp * 32 + l31) * 8, t0 = rb * 32 + ((w >> 2) * 2 + h2) * 8;
            if (grp == 0) pool_rows<2>(proj, mix, p.pool_b, p.pool_s, t0, c0);
            else if (grp == 1) pool_rows<4>(proj, mix, p.pool_b, p.pool_s, t0, c0);
            else if (grp == 2) pool_rows<8>(proj, mix, p.pool_b, p.pool_s, t0, c0);
            else pool_rows<16>(proj, mix, p.pool_b, p.pool_s, t0, c0);
        }
    }
}

DI void ln_phase(float* io, const float* g, const float* bta, bf16_t* h, const float* mod  , float2* stats) {
    const int tid = tid_opaque(), lane = tid & 63, gw = blockIdx.x * (NT / 64) + (tid >> 6), nw = gridDim.x * (NT / 64);
    for (int row0 = gw; row0 < T; row0 += 2 * nw) {
        float4 v[2][4];
#pragma unroll
        for (int r = 0; r < 2; ++r) {
            const int row = row0 + r * nw;
            if (row < T) {
#pragma unroll
                for (int c = 0; c < 4; ++c) v[r][c] = *(const float4*)(io + (size_t)row * 1024 + 4 * lane + 256 * c);
            }
        }
#pragma unroll
        for (int r = 0; r < 2; ++r) {
            const int row = row0 + r * nw;
            if (row < T) {
                float* rp = io + (size_t)row * 1024 + 4 * lane;
                float s = 0.f;
#pragma unroll
                for (int c = 0; c < 4; ++c) s += v[r][c].x + v[r][c].y + v[r][c].z + v[r][c].w;
                const float mu = wsum(s) * (1.f / 1024.f);
                float q = 0.f;
#pragma unroll
                for (int c = 0; c < 4; ++c) { v[r][c].x -= mu; v[r][c].y -= mu; v[r][c].z -= mu; v[r][c].w -= mu; q += v[r][c].x * v[r][c].x + v[r][c].y * v[r][c].y + v[r][c].z * v[r][c].z + v[r][c].w * v[r][c].w; }
                const float rstd = rsqrtf(wsum(q) * (1.f / 1024.f) + 1e-5f);
                const int b = row >> 12;
                if (stats && lane == 0) stats[row] = make_float2(mu, rstd);
#pragma unroll
                for (int c = 0; c < 4; ++c) {
                    const int col = 4 * lane + 256 * c;
                    const float4 gv = *(const float4*)(g + col), bv = *(const float4*)(bta + col);
                    float4 o;
                    o.x = v[r][c].x * rstd * gv.x + bv.x; o.y = v[r][c].y * rstd * gv.y + bv.y; o.z = v[r][c].z * rstd * gv.z + bv.z; o.w = v[r][c].w * rstd * gv.w + bv.w;
                    if (!stats) { const f32x4 o_ = {o.x, o.y, o.z, o.w}; __builtin_nontemporal_store(o_, (f32x4*)(rp + 256 * c)); }
                    if (h) {
                        const float4 sh = *(const float4*)(mod + b * 3072 + col), sc = *(const float4*)(mod + b * 3072 + 1024 + col);
                        uint2 hv = {pk2(o.x * (1.f + sc.x) + sh.x, o.y * (1.f + sc.y) + sh.y), pk2(o.z * (1.f + sc.z) + sh.z, o.w * (1.f + sc.w) + sh.w)};
                        *(uint2*)(h + (size_t)row * 1024 + col) = hv;
                    }
                }
            }
        }
    }
}

DI void phase7(const Params& p, char* smem) {
    const int tid = tid_opaque(), lane = tid & 63, w = tid >> 6;
    const bf16_t* qc = (const bf16_t*)(p.ws + OFF_QC);
    const bf16_t* kvr = (const bf16_t*)(p.ws + OFF_KVR);
    bf16_t* qcn = (bf16_t*)(p.ws + OFF_QCN);
    bf16_t* Kb = (bf16_t*)(p.ws + OFF_KB);
    float* cosT = (float*)(p.ws + OFF_COS);
    float* sinT = (float*)(p.ws + OFF_SIN);
    for (int it = blockIdx.x; it < T / 64; it += gridDim.x) {
        const int t0 = it * 64;
        uint2 qv[8]; unsigned kvv[8]; int posv[8]; unsigned short k1v[8], k2v[8];
#pragma unroll
        for (int i = 0; i < 8; ++i) {
            const int t = t0 + w * 8 + i;
            qv[i] = *(const uint2*)(qc + (size_t)t * 256 + 4 * lane);
            kvv[i] = *(const unsigned*)(kvr + (size_t)t * 256 + 2 * lane);
            posv[i] = p.pos[t];
            k1v[i] = kvr[(size_t)t * 256 + 128 + (lane & 31)]; k2v[i] = kvr[(size_t)t * 256 + 160 + (lane & 31)];
        }
        const float4 gq = *(const float4*)(p.qn_g + 4 * lane);
        const float2 gk = *(const float2*)(p.kvn_g + 2 * lane);
        const double inv = exp2(-(double)(lane & 31) * (13.287712379549449 / 32.0));
#pragma unroll
        for (int i = 0; i < 8; ++i) {
            const int t = t0 + w * 8 + i;
            {
                const uint2 v = qv[i];
                const float f0 = bflo(v.x), f1 = bfhi(v.x), f2 = bflo(v.y), f3 = bfhi(v.y);
                const float rs = rsqrtf(wsum(f0 * f0 + f1 * f1 + f2 * f2 + f3 * f3) * (1.f / 256.f) + 1e-5f);
                uint2 o = {pk2(f0 * rs * gq.x, f1 * rs * gq.y), pk2(f2 * rs * gq.z, f3 * rs * gq.w)};
                *(uint2*)(qcn + (size_t)t * 256 + 4 * lane) = o;
            }
            {
                const unsigned v = kvv[i];
                const float f0 = bflo(v), f1 = bfhi(v);
                const float rs = rsqrtf(wsum(f0 * f0 + f1 * f1) * (1.f / 128.f) + 1e-5f);
                const unsigned o = pk2(f0 * rs * gk.x, f1 * rs * gk.y);
                *(unsigned*)(Kb + (size_t)t * 192 + 2 * lane) = o;
            }
            if (lane < 32) {
                const double ang = (double)posv[i] * inv;
                const double n = rint(ang * 0.15915494309189535);
                const float rr = (float)(ang - n * 6.283185307179586);
                float sn, cs;
                sincosf(rr, &sn, &cs);
                cosT[(size_t)t * 32 + lane] = cs; sinT[(size_t)t * 32 + lane] = sn;
                const float x1 = bf2f(k1v[i]), x2 = bf2f(k2v[i]);
                Kb[(size_t)t * 192 + 128 + lane] = (bf16_t)(pk2(x1 * cs - x2 * sn, 0.f) & 0xffffu);
                Kb[(size_t)t * 192 + 160 + lane] = (bf16_t)(pk2(x2 * cs + x1 * sn, 0.f) & 0xffffu);
            }
        }
    }
}

constexpr int ATT_ROPE_OFF = 16384, ATT_STAGE_B = 24576;
typedef unsigned long long u64_t;
#define TR8_ISSUE(R, OFF) asm volatile( \
    "ds_read_b64_tr_b16 %0, %8 offset:%16\n\tds_read_b64_tr_b16 %1, %9 offset:%16\n\tds_read_b64_tr_b16 %2, %10 offset:%16\n\tds_read_b64_tr_b16 %3, %11 offset:%16\n\t" \
    "ds_read_b64_tr_b16 %4, %12 offset:%16\n\tds_read_b64_tr_b16 %5, %13 offset:%16\n\tds_read_b64_tr_b16 %6, %14 offset:%16\n\tds_read_b64_tr_b16 %7, %15 offset:%16" \
    : "=&v"(R[0]), "=&v"(R[1]), "=&v"(R[2]), "=&v"(R[3]), "=&v"(R[4]), "=&v"(R[5]), "=&v"(R[6]), "=&v"(R[7]) \
    : "v"(va[0]), "v"(va[1]), "v"(va[2]), "v"(va[3]), "v"(va[4]), "v"(va[5]), "v"(va[6]), "v"(va[7]), "i"(OFF))
#define TR8_WAIT(R, N) asm volatile("s_waitcnt lgkmcnt(%8)" \
    : "+v"(R[0]), "+v"(R[1]), "+v"(R[2]), "+v"(R[3]), "+v"(R[4]), "+v"(R[5]), "+v"(R[6]), "+v"(R[7]) : "i"(N))
DI bf16x8 cat8u(u64_t lo, u64_t hi) { typedef u64_t u64x2 __attribute__((ext_vector_type(2))); u64x2 u = {lo, hi}; return __builtin_bit_cast(bf16x8, u); }
template <int BUF>
DI void att_tile(char* smem, const bf16x8 (&qf)[12], f32x16 (&oacc)[4], float& m, float& l, unsigned rowA0, unsigned ropeA0, const unsigned (&va)[8]) {
    constexpr int SB = BUF * ATT_STAGE_B;
    const char* sb = smem + SB;
    asm volatile("" : "+v"(rowA0), "+v"(ropeA0));
    f32x16 s0 = zero16(), s1 = zero16();
    bf16x8 ka0 = *(const bf16x8*)(sb + rowA0), ka1 = *(const bf16x8*)(sb + 8192 + rowA0);
#pragma unroll
    for (int kk = 0; kk < 12; ++kk) {
        bf16x8 kb0 = ka0, kb1 = ka1;
        if (kk + 1 < 8) { kb0 = *(const bf16x8*)(sb + (rowA0 ^ (32u * (kk + 1)))); kb1 = *(const bf16x8*)(sb + 8192 + (rowA0 ^ (32u * (kk + 1)))); }
        else if (kk + 1 < 12) { kb0 = *(const bf16x8*)(sb + (ropeA0 ^ (32u * (kk - 7)))); kb1 = *(const bf16x8*)(sb + 4096 + (ropeA0 ^ (32u * (kk - 7)))); }
        s0 = MFMA(ka0, qf[kk], s0);
        s1 = MFMA(ka1, qf[kk], s1);
        ka0 = kb0; ka1 = kb1;
    }
    u64_t ra[8], rb[8];
    TR8_ISSUE(ra, SB);
    float mx = fmaxf(s0[0], s1[0]);
#pragma unroll
    for (int i = 1; i < 16; ++i) mx = fmaxf(mx, fmaxf(s0[i], s1[i]));
    {
        const auto r_ = __builtin_amdgcn_permlane32_swap(__float_as_uint(mx), __float_as_uint(mx), false, false);
        mx = fmaxf(__uint_as_float(r_[0]), __uint_as_float(r_[1]));
    }
    if (__any(mx > m + 8.f)) {
        const float mn = fmaxf(m, mx);
        const float alpha = __builtin_amdgcn_exp2f(m - mn);
        m = mn;
        l *= alpha;
#pragma unroll
        for (int dt = 0; dt < 4; ++dt)
#pragma unroll
            for (int i = 0; i < 16; ++i) oacc[dt][i] *= alpha;
    }
    float ls0 = 0.f, ls1 = 0.f;
#pragma unroll
    for (int i = 0; i < 16; ++i) { s0[i] = __builtin_amdgcn_exp2f(s0[i] - m); ls0 += s0[i]; }
#pragma unroll
    for (int i = 0; i < 16; ++i) { s1[i] = __builtin_amdgcn_exp2f(s1[i] - m); ls1 += s1[i]; }
    l += ls0 + ls1;
    bf16x8 pf[4];
    pf[0] = pack8(s0[0], s0[1], s0[2], s0[3], s0[4], s0[5], s0[6], s0[7]);
    pf[1] = pack8(s0[8], s0[9], s0[10], s0[11], s0[12], s0[13], s0[14], s0[15]);
    pf[2] = pack8(s1[0], s1[1], s1[2], s1[3], s1[4], s1[5], s1[6], s1[7]);
    pf[3] = pack8(s1[8], s1[9], s1[10], s1[11], s1[12], s1[13], s1[14], s1[15]);
    TR8_ISSUE(rb, SB + 4096);
    TR8_WAIT(ra, 8);
#pragma unroll
    for (int dt = 0; dt < 4; ++dt) oacc[dt] = MFMA(cat8u(ra[2 * dt], ra[2 * dt + 1]), pf[0], oacc[dt]);
    TR8_ISSUE(ra, SB + 8192);
    TR8_WAIT(rb, 8);
#pragma unroll
    for (int dt = 0; dt < 4; ++dt) oacc[dt] = MFMA(cat8u(rb[2 * dt], rb[2 * dt + 1]), pf[1], oacc[dt]);
    TR8_ISSUE(rb, SB + 8192 + 4096);
    TR8_WAIT(ra, 8);
#pragma unroll
    for (int dt = 0; dt < 4; ++dt) oacc[dt] = MFMA(cat8u(ra[2 * dt], ra[2 * dt + 1]), pf[2], oacc[dt]);
    TR8_WAIT(rb, 0);
#pragma unroll
    for (int dt = 0; dt < 4; ++dt) oacc[dt] = MFMA(cat8u(rb[2 * dt], rb[2 * dt + 1]), pf[3], oacc[dt]);
}

DI void phase9(const Params& p, char* smem) {
    const int tid = tid_opaque(), lane = tid & 63, w = tid >> 6, l31 = lane & 31, h2 = lane >> 5;
    const bf16_t* Q = (const bf16_t*)(p.ws + OFF_Q);
    const bf16_t* Kb = (const bf16_t*)(p.ws + OFF_KB);
    const bf16_t* Bt5 = (const bf16_t*)(p.ws + OFF_BT5);
    const bf16_t* zs = (const bf16_t*)(p.ws + OFF_ZS);
    bf16_t* og = (bf16_t*)(p.ws + OFF_MIX);
    constexpr int ROPE_OFF = ATT_ROPE_OFF, RRS = 128, STAGE = ATT_STAGE_B;
    const unsigned xr = ((l31 & 3) << 2) | ((l31 >> 2) & 3);
    const unsigned rowA0 = 256u * l31 + 16u * (h2 ^ (xr & 1)) + 32u * (xr >> 1);
    const unsigned xr2 = (l31 >> 1) & 7;
    const unsigned ropeA0 = ROPE_OFF + l31 * RRS + 16u * (h2 ^ (xr2 & 1)) + 16u * (xr2 & 6);
    const unsigned q4 = (lane & 15) >> 2, pp = lane & 3, lo = 2 * ((lane >> 4) & 1) + (pp >> 1);
    unsigned va[8];
    {
        const unsigned vbase = (unsigned)(size_t)smem + 1024u * h2 + 256u * q4 + 8u * (pp & 1);
#pragma unroll
        for (int dt = 0; dt < 4; ++dt) { va[2 * dt] = vbase + 64u * (dt ^ q4) + 16u * (lo ^ h2); va[2 * dt + 1] = vbase + 2048u + 64u * (dt ^ q4) + 16u * (lo ^ (2u + h2)); }
    }
    const int G = gridDim.x;
    for (int j = 0;; ++j) {
        const int ii = (j & 1) ? (j * G + (G - 1 - (int)blockIdx.x)) : (j * G + (int)blockIdx.x);
        if (j * G >= 2048) break;
        if (ii >= 2048) continue;
        const int qb = 31 - (ii >> 6), bh = ii & 63, b = bh & 7, hh = (bh >> 3) * 2 + (w >> 2);
        const int trow = b * SEQ + qb * 128 + (w & 3) * 32 + l31;
        bf16x8 qf[12];
        {
            const bf16_t* qp = Q + qfo(trow, hh, 8 * h2);
#pragma unroll
            for (int kk = 0; kk < 12; ++kk) qf[kk] = *(const bf16x8*)(qp + 512 * kk);
        }
        f32x16 oacc[4];
#pragma unroll
        for (int dt = 0; dt < 4; ++dt) oacc[dt] = zero16();
        float m = -1e30f, l = 0.f;
        const int nkt = 2 * qb + 2, wl = 2 * qb + ((w & 3) >> 1);
        const bf16_t* Kbb = Kb + (size_t)b * SEQ * 192;
        unsigned ko0, ko1, ko2;
        {
            const unsigned sa = (unsigned)(w * 64 + lane), sb_ = sa + 512;
            const unsigned ra = (sa >> 4) & 31, rb_ = (sb_ >> 4) & 31;
            ko0 = 2 * (((sa >> 9) * 32 + ra) * 192 + 8 * ((sa & 15) ^ (((ra & 3) << 2) | ((ra >> 2) & 3))));
            ko1 = 2 * (((sb_ >> 9) * 32 + rb_) * 192 + 8 * ((sb_ & 15) ^ (((rb_ & 3) << 2) | ((rb_ >> 2) & 3))));
            const unsigned rr = sa >> 3;
            ko2 = 2 * (rr * 192 + 128 + 8 * ((sa & 7) ^ ((rr >> 1) & 7)));
        }
#define ATT_STAGE(buf_, kt_) do { const char* g_ = (const char*)(Kbb + (size_t)(kt_) * 64 * 192); LAS unsigned* d_ = (LAS unsigned*)(smem + (buf_) * STAGE + w * 1024);             __builtin_amdgcn_global_load_lds((const unsigned*)(g_ + ko0), d_, 16, 0, 0);             __builtin_amdgcn_global_load_lds((const unsigned*)(g_ + ko1), d_ + 2048, 16, 0, 0);             __builtin_amdgcn_global_load_lds((const unsigned*)(g_ + ko2), d_ + 4096, 16, 0, 0); } while (0)
        ATT_STAGE(0, 0);
        __syncthreads();
        for (int kt = 0; kt < nkt; kt += 2) {
            ATT_STAGE(1, kt + 1);
            if (kt <= wl) att_tile<0>(smem, qf, oacc, m, l, rowA0, ropeA0, va);
            __syncthreads();
            if (kt + 2 < nkt) ATT_STAGE(0, kt + 2);
            if (kt + 1 <= wl) att_tile<1>(smem, qf, oacc, m, l, rowA0, ropeA0, va);
            __syncthreads();
        }
#undef ATT_STAGE
        const float inv = 1.f / (l + __shfl_xor(l, 32));
        const int te_ = tid_opaque(), l31e = te_ & 31, h2e = (te_ >> 5) & 1, we = te_ >> 6;
        const int trowe = b * SEQ + qb * 128 + (we & 3) * 32 + l31e;
        const int rr = (te_ >> 4) & 3, ch = te_ & 15;
        const int trow0 = b * SEQ + qb * 128 + (we & 3) * 32;
        const bf16_t* zp = zs + ((size_t)((trow0 >> 12) * 16 + hh) * SEQ + (trow0 & (SEQ - 1)) + rr) * 128 + ch * 8;
        const uint4 zq0 = *(const uint4*)(zp), zq1 = *(const uint4*)(zp + 512), zq2 = *(const uint4*)(zp + 1024), zq3 = *(const uint4*)(zp + 1536);
        const uint4 zq4 = *(const uint4*)(zp + 2048), zq5 = *(const uint4*)(zp + 2560), zq6 = *(const uint4*)(zp + 3072), zq7 = *(const uint4*)(zp + 3584);
        bf16x8 of[8];
#pragma unroll
        for (int dt = 0; dt < 4; ++dt) {
            of[2 * dt] = pack8(oacc[dt][0] * inv, oacc[dt][1] * inv, oacc[dt][2] * inv, oacc[dt][3] * inv, oacc[dt][4] * inv, oacc[dt][5] * inv, oacc[dt][6] * inv, oacc[dt][7] * inv);
            of[2 * dt + 1] = pack8(oacc[dt][8] * inv, oacc[dt][9] * inv, oacc[dt][10] * inv, oacc[dt][11] * inv, oacc[dt][12] * inv, oacc[dt][13] * inv, oacc[dt][14] * inv, oacc[dt][15] * inv);
        }
        char* ot = smem + 49152 + we * 8704;
#pragma unroll
        for (int d2 = 0; d2 < 4; ++d2) {
            f32x16 o = zero16();
            const bf16_t* wp = Bt5 + ((size_t)((hh * 4 + d2) * 8) * 2 + h2e) * 256 + l31e * 8;
#pragma unroll
            for (int ks = 0; ks < 8; ++ks) {
                o = MFMA(*(const bf16x8*)(wp + 512 * ks), of[ks], o);
            }
#pragma unroll
            for (int g = 0; g < 2; ++g) {
                uint4 hv = {pkh2(o[8 * g], o[8 * g + 1]), pkh2(o[8 * g + 2], o[8 * g + 3]), pkh2(o[8 * g + 4], o[8 * g + 5]), pkh2(o[8 * g + 6], o[8 * g + 7])};
                *(uint4*)(ot + l31e * 272 + (16 * h2e + d2 * 32 + 8 * g) * 2) = hv;
            }
        }
        {
            bf16_t* op = og + (size_t)(trow0 + rr) * 2048 + hh * 128 + ch * 8;
            const char* orow = ot + rr * 272 + ch * 16;
#define ATT_FIN(pi, zv) do { const uint4 ov = *(const uint4*)(orow + (pi) * 4 * 272); \
                uint4 r = {pk2(hlo(ov.x) * bflo(zv.x), hhi(ov.x) * bfhi(zv.x)), pk2(hlo(ov.y) * bflo(zv.y), hhi(ov.y) * bfhi(zv.y)), \
                           pk2(hlo(ov.z) * bflo(zv.z), hhi(ov.z) * bfhi(zv.z)), pk2(hlo(ov.w) * bflo(zv.w), hhi(ov.w) * bfhi(zv.w))}; \
                *(uint4*)(op + (size_t)(pi) * 4 * 2048) = r; } while (0)
            ATT_FIN(0, zq0); ATT_FIN(1, zq1); ATT_FIN(2, zq2); ATT_FIN(3, zq3); ATT_FIN(4, zq4); ATT_FIN(5, zq5); ATT_FIN(6, zq6); ATT_FIN(7, zq7);
#undef ATT_FIN
        }
    }
}

#define XB_TMO      128
#define XB_XCNT(j)  (256  + 64 * (j))
#define XB_XSUB(j)  (1280 + 64 * (j))
#define XB_XGEN(j)  (2304 + 64 * (j))
#define XB_TOP      3328
#define XB_TOPGEN   3392
#define XCD_BAR_WORDS 3456
#define XB_SPIN_CAP (1u << 18)
DI unsigned xb_ld(unsigned* p)              { return __hip_atomic_load(p, __ATOMIC_RELAXED, __HIP_MEMORY_SCOPE_AGENT); }
DI unsigned xb_add(unsigned* p, unsigned v) { return __hip_atomic_fetch_add(p, v, __ATOMIC_RELAXED, __HIP_MEMORY_SCOPE_AGENT); }
DI unsigned xb_xcc_id() { return (unsigned)__builtin_amdgcn_s_getreg((3 << 11) | 20) & 0xFu; }
#define XB_SPIN(cond, bar) do { unsigned _sp = 0; while (cond) { __builtin_amdgcn_s_sleep(1); \
    if ((++_sp & 255u) == 0u) { if (xb_ld(&(bar)[XB_TMO])) break; if (_sp > XB_SPIN_CAP) { atomicAdd(&(bar)[XB_TMO], 1u); break; } } } } while (0)
struct XcdBarrier { unsigned* bar; unsigned x; volatile LAS unsigned* st; };
DI XcdBarrier xcd_barrier_post(unsigned* bar, volatile LAS unsigned* st) {
    XcdBarrier b; b.bar = bar; b.x = xb_xcc_id(); b.st = st;
    if (threadIdx.x == 0) (void)xb_add(&bar[XB_XCNT(b.x)], 1u);
    return b;
}
DI void xcd_barrier_complete(unsigned* bar, unsigned x, unsigned& nloc, unsigned& nx) {
    const unsigned G = gridDim.x * gridDim.y * gridDim.z;
    unsigned sum, cnt, mine, sp = 0u;
    for (;;) {
        sum = 0u; cnt = 0u; mine = 0u;
#pragma unroll
        for (unsigned j = 0; j < 16; ++j) { const unsigned c = xb_ld(&bar[XB_XCNT(j)]); sum += c; cnt += (c > 0u) ? 1u : 0u; mine = (j == x) ? c : mine; }
        if (sum == G) break;
        __builtin_amdgcn_s_sleep(1);
        if ((++sp & 255u) == 0u) { if (xb_ld(&bar[XB_TMO])) break; if (sp > XB_SPIN_CAP) { atomicAdd(&bar[XB_TMO], 1u); break; } }
    }
    nloc = mine > 0u ? mine : 1u; nx = cnt > 0u ? cnt : 1u;
}
DI void xcd_barrier(const XcdBarrier& b) {
    asm volatile("s_waitcnt vmcnt(0)" ::: "memory");
    __syncthreads();
    if (threadIdx.x == 0) {
        unsigned* bar = b.bar;
        __builtin_amdgcn_s_waitcnt(0);
        unsigned nloc = b.st[0], nx = b.st[1];
        if (nloc == 0u) { xcd_barrier_complete(bar, b.x, nloc, nx); b.st[0] = nloc; b.st[1] = nx; }
        const unsigned old = xb_add(&bar[XB_XSUB(b.x)], 1u);
        const unsigned gen = old / nloc;
        if (old + 1u == (gen + 1u) * nloc) {
            __builtin_amdgcn_fence(__ATOMIC_RELEASE, "agent");
            asm volatile("s_waitcnt vmcnt(0)" ::: "memory");
            const unsigned og = xb_add(&bar[XB_TOP], 1u);
            const unsigned tg = og / nx;
            if (og + 1u == (tg + 1u) * nx) xb_add(&bar[XB_TOPGEN], 1u);
            else XB_SPIN(xb_ld(&bar[XB_TOPGEN]) == tg, bar);
            __builtin_amdgcn_fence(__ATOMIC_ACQUIRE, "agent");
            xb_add(&bar[XB_XGEN(b.x)], 1u);
            asm volatile("s_waitcnt vmcnt(0)" ::: "memory");
        } else {
            XB_SPIN(xb_ld(&bar[XB_XGEN(b.x)]) == gen, bar);
            __builtin_amdgcn_fence(__ATOMIC_ACQUIRE, "agent");
            asm volatile("s_waitcnt vmcnt(0)" ::: "memory");
        }
    }
    __syncthreads();
}

template <class Epi>
DI void run_gemm(const bf16_t* A, const bf16_t* Bt, int N, int K, const Epi& e, char* smem) {
    pg8::Gemm g{A, Bt, T, N, K};
    pg8::StaticOrder so; so.init(T, N, (int)gridDim.x, (int)blockIdx.x);
    pg8::gemm_phase((PG8_LAS unsigned char*)smem, g, so, e);
    __syncthreads();
}
template <int PH>
DI void run_phase(const Params& p, char* smem) {
    char* ws = p.ws;
    float* mod = (float*)(ws + OFF_MOD);
    if (PH == 0) phase0(p, smem);
    if (PH == 1) phase1(p);
    if (PH == 2) { Epi1 e{(bf16_t*)(ws + OFF_P0)}; run_gemm((const bf16_t*)(ws + OFF_H0), (const bf16_t*)(ws + OFF_BT1), 5120, 1024, e, smem); }
    if (PH == 3) phase3(p, smem, 0, 2048);
    if (PH == 4) { EpiRes e{p.x, p.out, mod + 2048}; run_gemm((const bf16_t*)(ws + OFF_MIX), (const bf16_t*)(ws + OFF_BT2), 1024, 2048, e, smem); }
    if (PH == 5) ln_phase(p.out, p.ln_g, p.ln_b, (bf16_t*)(ws + OFF_H1), mod + 8 * 3072, (float2*)(ws + OFF_STATS));
    if (PH == 6) { Epi3 e{(bf16_t*)(ws + OFF_ZS), (bf16_t*)(ws + OFF_QC), (bf16_t*)(ws + OFF_KVR)}; run_gemm((const bf16_t*)(ws + OFF_H1), (const bf16_t*)(ws + OFF_BT3), 2560, 1024, e, smem); }
    if (PH == 7) phase7(p, smem);
    if (PH == 8) { Epi4 e{(bf16_t*)(ws + OFF_Q), (const float*)(ws + OFF_COS), (const float*)(ws + OFF_SIN)}; run_gemm((const bf16_t*)(ws + OFF_QCN), (const bf16_t*)(ws + OFF_BT4), 3072, 256, e, smem); }
    if (PH == 9) phase9(p, smem);
    if (PH == 10) { EpiResLn e{p.out, (const float2*)(ws + OFF_STATS), p.ln_g, p.ln_b, mod + 8 * 3072 + 2048}; run_gemm((const bf16_t*)(ws + OFF_MIX), (const bf16_t*)(ws + OFF_BT6), 1024, 2048, e, smem); }
    if (PH == 11) ln_phase(p.out, p.ln_g + 1024, p.ln_b + 1024, nullptr, nullptr, nullptr);
}

extern __shared__ __attribute__((aligned(16))) char dyn_smem[];

__global__ void __launch_bounds__(NT) fwd_megakernel(Params p) {
    cg::grid_group grid = cg::this_grid();
    volatile LAS unsigned* st = (volatile LAS unsigned*)((LAS unsigned char*)dyn_smem + (LDS_BYTES - 16));
    if (threadIdx.x == 0) { st[0] = 0u; st[1] = 0u; }
    __syncthreads();
    const XcdBarrier xb = xcd_barrier_post((unsigned*)(p.ws + OFF_BAR), st);
    if (p.out == nullptr) grid.sync();
    run_phase<0>(p, dyn_smem); xcd_barrier(xb);
    run_phase<1>(p, dyn_smem); xcd_barrier(xb);
    run_phase<2>(p, dyn_smem); xcd_barrier(xb);
    run_phase<3>(p, dyn_smem); xcd_barrier(xb);
    run_phase<4>(p, dyn_smem); xcd_barrier(xb);
    run_phase<5>(p, dyn_smem); xcd_barrier(xb);
    run_phase<6>(p, dyn_smem); xcd_barrier(xb);
    run_phase<7>(p, dyn_smem); xcd_barrier(xb);
    run_phase<8>(p, dyn_smem); xcd_barrier(xb);
    run_phase<9>(p, dyn_smem); xcd_barrier(xb);
    run_phase<10>(p, dyn_smem); xcd_barrier(xb);
    run_phase<11>(p, dyn_smem);
}

extern "C" void kernel_launch(void* const* d_in, const int* in_sizes, int n_in, void* d_out, int out_size, void* d_ws, size_t ws_size, hipStream_t stream) {
    static int grid_blocks = 0;
    if (!grid_blocks) {
        hipFuncSetAttribute((const void*)fwd_megakernel, hipFuncAttributeMaxDynamicSharedMemorySize, LDS_BYTES);
        int dev = 0, cus = 0, per_cu = 0;
        hipGetDevice(&dev);
        hipDeviceGetAttribute(&cus, hipDeviceAttributeMultiprocessorCount, dev);
        hipOccupancyMaxActiveBlocksPerMultiprocessor(&per_cu, fwd_megakernel, NT, LDS_BYTES);
        if (per_cu < 1) per_cu = 1;
        grid_blocks = cus * 1;
    }
    if (ws_size < WS_NEED) { fprintf(stderr, "workspace too small: %zu < %zu\n", ws_size, (size_t)WS_NEED); return; }
    Params p{};
    p.x = (const float*)d_in[0]; p.c = (const float*)d_in[1]; p.pos = (const int*)d_in[2];
    p.ada_w = (const float*)d_in[3]; p.ada_b = (const float*)d_in[4]; p.ln_g = (const float*)d_in[5]; p.ln_b = (const float*)d_in[6];
    p.e_w_in = (const float*)d_in[7]; p.gn_g = (const float*)d_in[8]; p.gn_b = (const float*)d_in[9]; p.g_ws = (const float*)d_in[10]; p.g_bs = (const float*)d_in[11];
    p.pool_w = (const float*)d_in[12]; p.pool_b = (const float*)d_in[13]; p.pool_s = (const float*)d_in[14]; p.e_w_out = (const float*)d_in[15];
    p.o_w_in = (const float*)d_in[16]; p.qn_g = (const float*)d_in[17]; p.kvn_g = (const float*)d_in[18]; p.w_uq = (const float*)d_in[19];
    p.w_uk = (const float*)d_in[20]; p.w_uv = (const float*)d_in[21]; p.o_w_out = (const float*)d_in[22];
    p.out = (float*)d_out; p.ws = (char*)d_ws;
    hipMemsetAsync((char*)d_ws + OFF_BAR, 0, XCD_BAR_WORDS * sizeof(unsigned), stream);
    void* args[] = {&p};
    hipError_t e = hipLaunchCooperativeKernel((const void*)fwd_megakernel, dim3(grid_blocks), dim3(NT), args, LDS_BYTES, stream);
    if (e != hipSuccess) fprintf(stderr, "cooperative launch failed: %s (grid %d)\n", hipGetErrorString(e), grid_blocks);
}
```

```cpp
#include <hip/hip_runtime.h>
#include <hip/hip_cooperative_groups.h>
#include <cstdio>
namespace cg = cooperative_groups;

#define DI __device__ __forceinline__
typedef unsigned short bf16_t;
typedef short bf16x8 __attribute__((ext_vector_type(8)));
typedef float f32x16 __attribute__((ext_vector_type(16)));
typedef float f32x2 __attribute__((ext_vector_type(2)));
typedef __bf16 bf16x2v __attribute__((ext_vector_type(2)));
#define MFMA(a, b, c) __builtin_amdgcn_mfma_f32_32x32x16_bf16((a), (b), (c), 0, 0, 0)

constexpr int NT = 512;
constexpr int T = 32768, SEQ = 4096;
constexpr float ALPHA = 1.4142135623730951f;
constexpr float QSCALE = 0.07216878364870322f * 1.4426950408889634f;
constexpr size_t MiB = 1024 * 1024;
constexpr size_t OFF_MOD = 0;
constexpr size_t OFF_BAR = 200 * 1024;
constexpr size_t OFF_WSB = 256 * 1024;
constexpr size_t OFF_RSW = 512 * 1024;
constexpr size_t OFF_STATS = 576 * 1024;
constexpr size_t OFF_BT1 = 1 * MiB;
constexpr size_t OFF_BT2 = 11 * MiB;
constexpr size_t OFF_BT3 = 15 * MiB;
constexpr size_t OFF_BT4 = 20 * MiB;
constexpr size_t OFF_BT5 = 22 * MiB;
constexpr size_t OFF_BT6 = 23 * MiB;
constexpr size_t OFF_P0 = 28 * MiB;
constexpr size_t OFF_ZS = 28 * MiB;
constexpr size_t OFF_Q = 156 * MiB;
constexpr size_t OFF_H1 = 156 * MiB;
constexpr size_t OFF_MIX = 348 * MiB;
constexpr size_t OFF_H0 = 348 * MiB;
constexpr size_t OFF_QC = 348 * MiB;
constexpr size_t OFF_KVR = 364 * MiB;
constexpr size_t OFF_QCN = 380 * MiB;
constexpr size_t OFF_COS = 396 * MiB;
constexpr size_t OFF_SIN = 400 * MiB;
constexpr size_t OFF_KB = 476 * MiB;
constexpr size_t OFF_VT = 488 * MiB;
constexpr size_t WS_NEED = 496 * MiB;
constexpr int LDS_BYTES = 147456;

struct Params {
    const float *x, *c; const int* pos;
    const float *ada_w, *ada_b, *ln_g, *ln_b, *e_w_in, *gn_g, *gn_b, *g_ws, *g_bs, *pool_w, *pool_b, *pool_s, *e_w_out;
    const float *o_w_in, *qn_g, *kvn_g, *w_uq, *w_uk, *w_uv, *o_w_out;
    float* out; char* ws;
};

DI unsigned pk2(float a, float b) { f32x2 v = {a, b}; bf16x2v r = __builtin_convertvector(v, bf16x2v); return __builtin_bit_cast(unsigned, r); }
DI int tid_opaque() { int t = threadIdx.x; asm volatile("" : "+v"(t)); return t; }
DI float bf2f(unsigned u16) { return __uint_as_float(u16 << 16); }
DI float bflo(unsigned u) { return __uint_as_float(u << 16); }
DI float bfhi(unsigned u) { return __uint_as_float(u & 0xffff0000u); }
DI float wsum(float v) {
#pragma unroll
    for (int o = 32; o; o >>= 1) v += __shfl_xor(v, o);
    return v;
}
DI float silu(float x) { return x * __builtin_amdgcn_rcpf(1.f + __builtin_amdgcn_exp2f(-1.4426950408889634f * x)); }
typedef short v4i16_t __attribute__((ext_vector_type(4)));
#define LAS __attribute__((address_space(3)))
DI uint2 tr_read(const char* p) { v4i16_t r = __builtin_amdgcn_ds_read_tr16_b64_v4i16((LAS v4i16_t*)p); return __builtin_bit_cast(uint2, r); }
DI unsigned off_b(unsigned row, unsigned ch) { return 256u * row + 16u * (ch ^ (((row & 3u) << 2) | ((row >> 2) & 3u))); }
DI bf16x8 cat8(uint2 lo, uint2 hi) { uint4 u = {lo.x, lo.y, hi.x, hi.y}; return __builtin_bit_cast(bf16x8, u); }
typedef _Float16 f16x2 __attribute__((ext_vector_type(2)));
DI unsigned pkh2(float a, float b) { f32x2 v = {a, b}; f16x2 r = __builtin_convertvector(v, f16x2); return __builtin_bit_cast(unsigned, r); }
DI float hlo(unsigned u) { f16x2 r = __builtin_bit_cast(f16x2, u); return (float)r.x; }
DI float hhi(unsigned u) { f16x2 r = __builtin_bit_cast(f16x2, u); return (float)r.y; }
DI int crow(int i, int h2) { return (i & 3) + 8 * (i >> 2) + 4 * h2; }
DI bf16x8 pack8(float a0, float a1, float a2, float a3, float a4, float a5, float a6, float a7) {
    uint4 u = {pk2(a0, a1), pk2(a2, a3), pk2(a4, a5), pk2(a6, a7)};
    return __builtin_bit_cast(bf16x8, u);
}
DI bf16x8 pack8v(float4 a, float4 b) { return pack8(a.x, a.y, a.z, a.w, b.x, b.y, b.z, b.w); }
DI f32x16 zero16() { f32x16 z;
#pragma unroll
    for (int i = 0; i < 16; ++i) z[i] = 0.f;
    return z; }

namespace pg8 {
#define PG8_LAS __attribute__((address_space(3)))
typedef float f32x4 __attribute__((ext_vector_type(4)));
typedef unsigned u32x4 __attribute__((ext_vector_type(4)));
constexpr int BM = 256, BK = 64, HALF = 128, HTB = HALF * BK * 2, STAGE_BYTES = 8 * HTB, NXCD = 8, WGM = 8;
DI int lds_byte(int r, int c) { const int st = (r >> 4) * 2 + (c >> 5), rr = r & 15, cc = c & 31, ob = rr * 64 + cc * 2; return st * 1024 + (ob ^ (((ob >> 9) & 1) << 5)); }
DI void stage_rc(int b, int& R, int& C) { const int st = b / 1024, sb = b % 1024, swz = sb ^ (((sb >> 9) & 1) << 5); R = (st >> 1) * 16 + swz / 64; C = (st & 1) * 32 + (swz % 64) / 2; }
DI int perm32(int rho) { const int n = rho >> 4, i = rho & 15; return 8 * (i >> 2) + 4 * n + (i & 3); }
struct Unit { int pm, pn; };
struct Gemm { const bf16_t* A; const bf16_t* Bt; int M, N, K; };
struct StaticOrder {
    int nM, nN, nwg, G, c;
    DI void init(int M, int N, int G_, int c_) { nM = M / BM; nN = N / BM; nwg = nM * nN; G = G_; c = c_; }
    DI bool next(int i, Unit& u) const {
        const long L = (long)i * G + c; if (L >= nwg) return false;
        int wgid = (int)L; { const int q = nwg / NXCD, r = nwg % NXCD, xcd = wgid % NXCD, off = wgid / NXCD; wgid = (xcd < r ? xcd * (q + 1) : r * (q + 1) + (xcd - r) * q) + off; }
        const int nig = WGM * nN, gid = wgid / nig, fm = gid * WGM, gsz = (nM - fm) < WGM ? (nM - fm) : WGM;
        u.pm = fm + ((wgid % nig) % gsz); u.pn = (wgid % nig) / gsz; return true;
    }
};
template <class Epi>
DI void gemm_phase(PG8_LAS unsigned char* lds, const Gemm g, const StaticOrder& S, const Epi& E) {
    const int tid = tid_opaque(), wid = __builtin_amdgcn_readfirstlane(tid >> 6), lane = tid & 63, wr = wid >> 2, wc = wid & 3, fr = lane & 15, fq = lane >> 4;
    const int K = g.K, nt = K / BK;
    unsigned voffA[2], voffB[2];
#pragma unroll
    for (int i = 0; i < 2; ++i) { int R, C; stage_rc(tid * 16 + i * 8192, R, C); const int Rb = (R & ~31) + perm32(R & 31);
        voffA[i] = (unsigned)(R * K + C) * 2u; voffB[i] = (unsigned)(Rb * K + C) * 2u; }
    const size_t kstep = (size_t)(BK * 2);
    const size_t hstep = (size_t)HALF * K * 2;
    const size_t tstep = 2 * hstep;
    const unsigned ldsw = (unsigned)wid * 1024u;
    const int aoff = lds_byte(wr * 64 + fr, fq * 8), boff = lds_byte(wc * 32 + fr, fq * 8);
#define PG8_SA(b, h) (((b) * 2 + (h)) * HTB)
#define PG8_SB(b, h) ((4 + (b) * 2 + (h)) * HTB)
#define PG8_STAGE(bufoff, gbase, voff) do { _Pragma("unroll") for (int _i = 0; _i < 2; ++_i) \
        __builtin_amdgcn_global_load_lds((const unsigned*)((const char*)(gbase) + (voff)[_i]), (PG8_LAS unsigned*)(lds + (bufoff) + ldsw + _i * 8192), 16, 0, 0); } while (0)
#define PG8_LDA(dst, b, h) do { _Pragma("unroll") for (int m = 0; m < 4; ++m) _Pragma("unroll") for (int k = 0; k < 2; ++k) dst[m][k] = *(const PG8_LAS bf16x8*)(lds + PG8_SA(b, h) + aoff + m * 2048 + k * 1024); } while (0)
#define PG8_LDB(dst, b, h) do { _Pragma("unroll") for (int n = 0; n < 2; ++n) _Pragma("unroll") for (int k = 0; k < 2; ++k) dst[n][k] = *(const PG8_LAS bf16x8*)(lds + PG8_SB(b, h) + boff + n * 2048 + k * 1024); } while (0)
#define PG8_MMA(ai, bj, At, Bt) do { __builtin_amdgcn_s_setprio(1); _Pragma("unroll") for (int m = 0; m < 4; ++m) _Pragma("unroll") for (int n = 0; n < 2; ++n) _Pragma("unroll") for (int k = 0; k < 2; ++k) \
        acc[ai][bj][m][n] = __builtin_amdgcn_mfma_f32_16x16x32_bf16(Bt[n][k], At[m][k], acc[ai][bj][m][n], 0, 0, 0); __builtin_amdgcn_s_setprio(0); } while (0)
#define PG8_WAIT_V(n) asm volatile("s_waitcnt vmcnt(" #n ")" ::: "memory")
#define PG8_WAIT_L(n) asm volatile("s_waitcnt lgkmcnt(" #n ")" ::: "memory")
#define PG8_BAR __builtin_amdgcn_s_barrier()
#define PG8_SCHED __builtin_amdgcn_sched_barrier(0)
    Unit cur, nxt; int ui = 0;
    if (!S.next(0, cur)) return;
    f32x4 acc[2][2][4][2];
#pragma unroll
    for (int a = 0; a < 2; ++a)
#pragma unroll
        for (int b = 0; b < 2; ++b)
#pragma unroll
            for (int m = 0; m < 4; ++m)
#pragma unroll
                for (int n = 0; n < 2; ++n) acc[a][b][m][n] = (f32x4){0.f, 0.f, 0.f, 0.f};
    bf16x8 At[4][2], B0[2][2], B1[2][2];
    const char* cA = (const char*)g.A + (size_t)cur.pm * tstep; const char* cB = (const char*)g.Bt + (size_t)cur.pn * tstep;
    PG8_STAGE(PG8_SB(0, 0), cB, voffB); PG8_STAGE(PG8_SA(0, 0), cA, voffA); PG8_STAGE(PG8_SB(0, 1), cB + hstep, voffB); PG8_STAGE(PG8_SA(0, 1), cA + hstep, voffA);
    if (wr == 1) PG8_BAR;
    PG8_WAIT_V(4); PG8_BAR;
    PG8_STAGE(PG8_SB(1, 0), cB + kstep, voffB); PG8_STAGE(PG8_SA(1, 0), cA + kstep, voffA); PG8_STAGE(PG8_SB(1, 1), cB + hstep + kstep, voffB);
    PG8_WAIT_V(6); PG8_BAR;
    for (;;) {
        const bool has_next = S.next(ui + 1, nxt);
        const char* nA = has_next ? (const char*)g.A + (size_t)nxt.pm * tstep : cA; const char* nB = has_next ? (const char*)g.Bt + (size_t)nxt.pn * tstep : cB;
        for (int t = 0; t < nt; t += 2) {
            const bool last = (t == nt - 2);
            const char* a1 = cA + (size_t)(t + 1) * kstep;
            const char* a2 = last ? nA : cA + (size_t)(t + 2) * kstep; const char* b2 = last ? nB : cB + (size_t)(t + 2) * kstep;
            const char* a3 = a2 + kstep; const char* b3 = b2 + kstep;
            PG8_LDB(B0, 0, 0); PG8_SCHED; PG8_LDA(At, 0, 0); PG8_STAGE(PG8_SA(1, 1), a1 + hstep, voffA);
            PG8_WAIT_L(8); PG8_BAR; PG8_WAIT_L(0); PG8_MMA(0, 0, At, B0); PG8_BAR; PG8_SCHED;
            PG8_LDB(B1, 0, 1); PG8_STAGE(PG8_SB(0, 0), b2, voffB);
            PG8_BAR; PG8_WAIT_L(0); PG8_MMA(0, 1, At, B1); PG8_BAR;
            PG8_LDA(At, 0, 1); PG8_STAGE(PG8_SA(0, 0), a2, voffA);
            PG8_BAR; PG8_WAIT_L(0); PG8_MMA(1, 0, At, B0); PG8_BAR; PG8_SCHED;
            PG8_STAGE(PG8_SB(0, 1), b2 + hstep, voffB);
            PG8_WAIT_V(6); PG8_BAR; PG8_MMA(1, 1, At, B1); PG8_BAR;
            PG8_LDB(B0, 1, 0); PG8_SCHED; PG8_LDA(At, 1, 0); PG8_STAGE(PG8_SA(0, 1), a2 + hstep, voffA);
            PG8_WAIT_L(8); PG8_BAR; PG8_WAIT_L(0); PG8_MMA(0, 0, At, B0); PG8_BAR; PG8_SCHED;
            PG8_LDB(B1, 1, 1); PG8_STAGE(PG8_SB(1, 0), b3, voffB);
            PG8_BAR; PG8_WAIT_L(0); PG8_MMA(0, 1, At, B1); PG8_BAR;
            PG8_LDA(At, 1, 1); PG8_STAGE(PG8_SA(1, 0), a3, voffA);
            PG8_BAR; PG8_WAIT_L(0); PG8_MMA(1, 0, At, B0); PG8_BAR; PG8_SCHED;
            PG8_STAGE(PG8_SB(1, 1), b3 + hstep, voffB);
            PG8_WAIT_V(6); PG8_BAR; PG8_MMA(1, 1, At, B1); PG8_BAR;
        }
        E(acc, cur, wr, wc, fr, fq);
        if (!has_next) break;
#pragma unroll
        for (int a = 0; a < 2; ++a)
#pragma unroll
            for (int b = 0; b < 2; ++b)
#pragma unroll
                for (int m = 0; m < 4; ++m)
#pragma unroll
                    for (int n = 0; n < 2; ++n) acc[a][b][m][n] = (f32x4){0.f, 0.f, 0.f, 0.f};
        cur = nxt; cA = nA; cB = nB; ++ui;
    }
    PG8_WAIT_V(0);
    if (wr == 0) PG8_BAR;
    PG8_BAR;
#undef PG8_SA
#undef PG8_SB
#undef PG8_STAGE
#undef PG8_LDA
#undef PG8_LDB
#undef PG8_MMA
#undef PG8_WAIT_V
#undef PG8_WAIT_L
#undef PG8_BAR
#undef PG8_SCHED
}
}
using pg8::f32x4;
typedef const f32x4 (&AccRef)[2][2][4][2];

DI uint4 pack8q(f32x4 a, f32x4 b) { uint4 u = {pk2(a[0], a[1]), pk2(a[2], a[3]), pk2(b[0], b[1]), pk2(b[2], b[3])}; return u; }
DI f32x4 silu4(f32x4 v) { f32x4 r = {silu(v[0]), silu(v[1]), silu(v[2]), silu(v[3])}; return r; }
struct Epi1 {
    bf16_t* proj;
    DI void operator()(AccRef acc, const pg8::Unit& u, int wr_, int wc_, int fr_, int fq_) const {
        const int t_ = tid_opaque(), wid_ = __builtin_amdgcn_readfirstlane(t_ >> 6), wr = wid_ >> 2, wc = wid_ & 3, fr = t_ & 15, fq = (t_ >> 4) & 3;
        const bool act = (u.pn >= 8 && u.pn < 12) || u.pn >= 16;
        bf16_t* p0 = proj + (size_t)(u.pm * 256 + wr * 64 + fr) * 5120 + u.pn * 256 + wc * 32 + 8 * fq;
#pragma unroll
        for (int ai = 0; ai < 2; ++ai)
#pragma unroll
            for (int m = 0; m < 4; ++m)
#pragma unroll
                for (int bj = 0; bj < 2; ++bj) {
                    f32x4 v0 = acc[ai][bj][m][0], v1 = acc[ai][bj][m][1];
                    if (act) { v0 = silu4(v0); v1 = silu4(v1); }
                    *(uint4*)(p0 + (size_t)(ai * 128 + m * 16) * 5120 + bj * 128) = pack8q(v0, v1);
                }
    }
};
struct EpiRes {
    const float* xin; float* out; const float* gate;
    DI void operator()(AccRef acc, const pg8::Unit& u, int wr_, int wc_, int fr_, int fq_) const {
        const int t_ = tid_opaque(), wid_ = __builtin_amdgcn_readfirstlane(t_ >> 6), wr = wid_ >> 2, wc = wid_ & 3, fr = t_ & 15, fq = (t_ >> 4) & 3;
        const int row0 = u.pm * 256 + wr * 64 + fr, col0 = u.pn * 256 + wc * 32 + 8 * fq, b = row0 >> 12;
        f32x4 gv[2][2];
#pragma unroll
        for (int bj = 0; bj < 2; ++bj) { gv[bj][0] = *(const f32x4*)(gate + b * 3072 + col0 + bj * 128) + 1.f; gv[bj][1] = *(const f32x4*)(gate + b * 3072 + col0 + bj * 128 + 4) + 1.f; }
        const float* xp = xin + (size_t)row0 * 1024 + col0;
        f32x4 c0 = *(const f32x4*)xp, c1 = *(const f32x4*)(xp + 4), c2 = *(const f32x4*)(xp + 128), c3 = *(const f32x4*)(xp + 132);
#pragma unroll
        for (int it = 0; it < 8; ++it) {
            const int ai = it >> 2, m = it & 3;
            const size_t off = (size_t)(row0 + ai * 128 + m * 16) * 1024 + col0;
            f32x4 n0 = c0, n1 = c1, n2 = c2, n3 = c3;
            if (it + 1 < 8) {
                const float* np = xin + (size_t)(row0 + ((it + 1) >> 2) * 128 + ((it + 1) & 3) * 16) * 1024 + col0;
                n0 = *(const f32x4*)np; n1 = *(const f32x4*)(np + 4); n2 = *(const f32x4*)(np + 128); n3 = *(const f32x4*)(np + 132);
            }
            asm volatile("" ::: "memory");
            *(f32x4*)(out + off) = c0 * ALPHA + gv[0][0] * acc[ai][0][m][0];
            *(f32x4*)(out + off + 4) = c1 * ALPHA + gv[0][1] * acc[ai][0][m][1];
            *(f32x4*)(out + off + 128) = c2 * ALPHA + gv[1][0] * acc[ai][1][m][0];
            *(f32x4*)(out + off + 132) = c3 * ALPHA + gv[1][1] * acc[ai][1][m][1];
            c0 = n0; c1 = n1; c2 = n2; c3 = n3;
        }
    }
};
struct EpiResLn {
    float* io; const float2* stats; const float *lng, *lnb, *gate;
    DI void operator()(AccRef acc, const pg8::Unit& u, int wr_, int wc_, int fr_, int fq_) const {
        const int t_ = tid_opaque(), wid_ = __builtin_amdgcn_readfirstlane(t_ >> 6), wr = wid_ >> 2, wc = wid_ & 3, fr = t_ & 15, fq = (t_ >> 4) & 3;
        const int row0 = u.pm * 256 + wr * 64 + fr, col0 = u.pn * 256 + wc * 32 + 8 * fq, b = row0 >> 12;
#pragma unroll
        for (int bj = 0; bj < 2; ++bj) {
            const int col = col0 + bj * 128;
            const f32x4 gv0 = *(const f32x4*)(gate + b * 3072 + col) + 1.f, gv1 = *(const f32x4*)(gate + b * 3072 + col + 4) + 1.f;
            const f32x4 lg0 = *(const f32x4*)(lng + col) * ALPHA, lg1 = *(const f32x4*)(lng + col + 4) * ALPHA;
            const f32x4 lb0 = *(const f32x4*)(lnb + col) * ALPHA, lb1 = *(const f32x4*)(lnb + col + 4) * ALPHA;
            float2 st = stats[row0];
            f32x4 r0 = *(const f32x4*)(io + (size_t)row0 * 1024 + col), r1 = *(const f32x4*)(io + (size_t)row0 * 1024 + col + 4);
#pragma unroll
            for (int it = 0; it < 8; ++it) {
                const int ai = it >> 2, m = it & 3;
                float* pp = io + (size_t)(row0 + ai * 128 + m * 16) * 1024 + col;
                float2 nst = st; f32x4 n0 = r0, n1 = r1;
                if (it + 1 < 8) {
                    const int nrow = row0 + ((it + 1) >> 2) * 128 + ((it + 1) & 3) * 16;
                    nst = stats[nrow]; n0 = *(const f32x4*)(io + (size_t)nrow * 1024 + col); n1 = *(const f32x4*)(io + (size_t)nrow * 1024 + col + 4);
                }
                asm volatile("" ::: "memory");
                *(f32x4*)pp = (r0 - st.x) * st.y * lg0 + lb0 + gv0 * acc[ai][bj][m][0];
                *(f32x4*)(pp + 4) = (r1 - st.x) * st.y * lg1 + lb1 + gv1 * acc[ai][bj][m][1];
                st = nst; r0 = n0; r1 = n1;
            }
        }
    }
};
struct Epi3 {
    bf16_t *zs, *qc, *kvr;
    DI void operator()(AccRef acc, const pg8::Unit& u, int wr_, int wc_, int fr_, int fq_) const {
        const int t_ = tid_opaque(), wid_ = __builtin_amdgcn_readfirstlane(t_ >> 6), wr = wid_ >> 2, wc = wid_ & 3, fr = t_ & 15, fq = (t_ >> 4) & 3;
        const int row0 = u.pm * 256 + wr * 64 + fr, cw = wc * 32 + 8 * fq;
        bf16_t* p0; int ld; size_t bjs = 128;
        if (u.pn < 8) { bjs = (size_t)SEQ * 128; p0 = zs + ((size_t)((row0 >> 12) * 16 + 2 * u.pn) * SEQ + (row0 & (SEQ - 1))) * 128 + cw; ld = 128; }
        else if (u.pn == 8) { p0 = qc + (size_t)row0 * 256 + cw; ld = 256; }
        else { p0 = kvr + (size_t)row0 * 256 + cw; ld = 256; }
        const bool act = u.pn < 8;
#pragma unroll
        for (int ai = 0; ai < 2; ++ai)
#pragma unroll
            for (int m = 0; m < 4; ++m)
#pragma unroll
                for (int bj = 0; bj < 2; ++bj) {
                    f32x4 v0 = acc[ai][bj][m][0], v1 = acc[ai][bj][m][1];
                    if (act) { v0 = silu4(v0); v1 = silu4(v1); }
                    *(uint4*)(p0 + (size_t)(ai * 128 + m * 16) * ld + bj * bjs) = pack8q(v0, v1);
                }
    }
};
DI size_t qfo(int row, int hh, int d) { return ((size_t)(((row >> 12) * 16 + hh) * 128 + ((row & (SEQ - 1)) >> 5)) * 6144) + (size_t)((d >> 3) * 256 + (row & 31) * 8); }
struct Epi4 {
    bf16_t* Q; const float *cosT, *sinT;
    DI void operator()(AccRef acc, const pg8::Unit& u, int wr_, int wc_, int fr_, int fq_) const {
        const int t_ = tid_opaque(), wid_ = __builtin_amdgcn_readfirstlane(t_ >> 6), wr = wid_ >> 2, wc = wid_ & 3, fr = t_ & 15, fq = (t_ >> 4) & 3;
        const int row0 = u.pm * 256 + wr * 64 + fr;
        if (u.pn < 8) {
#pragma unroll
            for (int ai = 0; ai < 2; ++ai)
#pragma unroll
                for (int m = 0; m < 4; ++m)
#pragma unroll
                    for (int bj = 0; bj < 2; ++bj) {
                        const int hh = 2 * u.pn + bj;
                        *(uint4*)(Q + qfo(row0 + ai * 128 + m * 16, hh, wc * 32 + 8 * fq)) = pack8q(acc[ai][bj][m][0] * QSCALE, acc[ai][bj][m][1] * QSCALE);
                    }
        } else {
            const int i0 = 4 * ((wc & 1) * 4 + fq);
            f32x4 cv8[8], sv8[8];
#pragma unroll
            for (int it = 0; it < 8; ++it) {
                const int row = row0 + (it >> 2) * 128 + (it & 3) * 16;
                cv8[it] = *(const f32x4*)(cosT + (size_t)row * 32 + i0); sv8[it] = *(const f32x4*)(sinT + (size_t)row * 32 + i0);
            }
#pragma unroll
            for (int it = 0; it < 8; ++it) {
                const int ai = it >> 2, m = it & 3;
                const int row = row0 + ai * 128 + m * 16;
                const f32x4 cv = cv8[it] * QSCALE, sv = sv8[it] * QSCALE;
#pragma unroll
                for (int bj = 0; bj < 2; ++bj) {
                    const int hh = (u.pn - 8) * 4 + bj * 2 + (wc >> 1);
                    const f32x4 x1 = acc[ai][bj][m][0], x2 = acc[ai][bj][m][1];
                    const f32x4 o1 = x1 * cv - x2 * sv, o2 = x2 * cv + x1 * sv;
                    bf16_t* qp = Q + qfo(row, hh, (128 + i0) & ~7) + (i0 & 7);
                    uint2 w1 = {pk2(o1[0], o1[1]), pk2(o1[2], o1[3])}, w2 = {pk2(o2[0], o2[1]), pk2(o2[2], o2[3])};
                    *(uint2*)qp = w1; *(uint2*)(qp + 1024) = w2;
                }
            }
        }
    }
};

DI void transpose_tile_wave(const float* __restrict__ src, int ld, int K, int kt, int c0, bf16_t* __restrict__ dst, int r0, bool ropeperm, bool kperm, float* tl, int lane) {
    float4 v[16];
#pragma unroll
    for (int i = 0; i < 16; ++i) { const int idx = lane + 64 * i, kr = idx >> 4, c4 = idx & 15; v[i] = *(const float4*)(src + (size_t)(kt * 64 + kr) * ld + c0 + 4 * c4); }
#pragma unroll
    for (int i = 0; i < 16; ++i) { const int idx = lane + 64 * i, kr = idx >> 4, c4 = idx & 15; float* d = tl + kr * 65 + 4 * c4; d[0] = v[i].x; d[1] = v[i].y; d[2] = v[i].z; d[3] = v[i].w; }
    const int n = lane;
    const int nd = ropeperm ? (8 * ((n & 31) >> 2) + 4 * (n >> 5) + (n & 3)) : n;
    bf16_t* dp = dst + (size_t)(r0 + nd) * K + kt * 64;
#pragma unroll
    for (int k8 = 0; k8 < 8; ++k8) {
        const float* s = tl + (k8 * 8) * 65 + n;
        uint4 o = {pk2(s[0], s[65]), pk2(s[130], s[195]), pk2(s[260], s[325]), pk2(s[390], s[455])};
        if (!kperm) *(uint4*)(dp + k8 * 8) = o;
        else {
            const int gn = r0 + n, hh_ = gn >> 7, dd = gn & 127, x = dd & 31;
            const int m_ = (((x >> 3) & 1) << 4) | (((x >> 2) & 1) << 3) | ((x >> 4) << 2) | (x & 3);
            const int ks_ = kt * 4 + (k8 >> 1);
            bf16_t* d2 = dst + ((size_t)(((hh_ * 4 + (dd >> 5)) * 8 + ks_) * 2) * 32 + m_) * 8 + (k8 & 1) * 4;
            *(uint2*)d2 = make_uint2(o.x, o.y); *(uint2*)(d2 + 256) = make_uint2(o.z, o.w);
        }
    }
}

DI void phase0(const Params& p, char* smem) {
    const int tid = tid_opaque(), lane = tid & 63, w = tid >> 6, l31 = lane & 31, h2 = lane >> 5;
    float* mod = (float*)(p.ws + OFF_MOD);
    bf16_t* Bt1 = (bf16_t*)(p.ws + OFF_BT1); bf16_t* Bt2 = (bf16_t*)(p.ws + OFF_BT2); bf16_t* Bt3 = (bf16_t*)(p.ws + OFF_BT3);
    bf16_t* Bt4 = (bf16_t*)(p.ws + OFF_BT4); bf16_t* Bt5 = (bf16_t*)(p.ws + OFF_BT5); bf16_t* Bt6 = (bf16_t*)(p.ws + OFF_BT6);
    bf16_t* Wsb = (bf16_t*)(p.ws + OFF_WSB);
    constexpr int N_ADA = 192, N_TR = 2800, N_FA = 64, N_FB = 128, N_MISC = 65;
    constexpr int TOTAL = N_ADA + N_FA + N_FB + N_MISC;
    for (int it = blockIdx.x; it < TOTAL; it += gridDim.x) {
        if (it < N_ADA) {
            const int l = it / 96, cb = it % 96;
            float* sc = (float*)smem;
            const int kg = tid >> 5, cl = tid & 31, col = cb * 32 + cl;
            const float* wp = p.ada_w + ((size_t)l * 1024 + kg * 64) * 3072 + col;
            float wv[64];
#pragma unroll
            for (int k = 0; k < 64; ++k) wv[k] = wp[(size_t)k * 3072];
#pragma unroll
            for (int i = 0; i < 16; ++i) { const int idx = tid + 512 * i; sc[idx] = silu(p.c[idx]); }
            __syncthreads();
            float a[8];
#pragma unroll
            for (int b = 0; b < 8; ++b) a[b] = 0.f;
#pragma unroll
            for (int k = 0; k < 64; ++k) {
#pragma unroll
                for (int b = 0; b < 8; ++b) a[b] += sc[b * 1024 + kg * 64 + k] * wv[k];
            }
            float* red = sc + 8192;
#pragma unroll
            for (int b = 0; b < 8; ++b) red[(kg * 8 + b) * 32 + cl] = a[b];
            __syncthreads();
            if (tid < 256) {
                const int b = tid >> 5;
                float s = p.ada_b[l * 3072 + col];
#pragma unroll
                for (int g = 0; g < 16; ++g) s += red[(g * 8 + b) * 32 + cl];
                mod[(l * 8 + b) * 3072 + col] = s;
            }
            __syncthreads();
        } else if (it < N_ADA + N_FA) {
            const int wt = (it - N_ADA) * 8 + w, hh = wt >> 5, rt = (wt >> 3) & 3, kt = wt & 7;
            f32x16 acc = zero16();
            const float* ap = p.w_uk + ((size_t)(rt * 32 + l31) * 16 + hh) * 128 + 8 * h2;
            const float* bp = p.w_uq + ((size_t)(kt * 32 + l31) * 16 + hh) * 192 + 8 * h2;
#pragma unroll
            for (int s = 0; s < 8; ++s) {
                const bf16x8 af = pack8v(*(const float4*)(ap + 16 * s), *(const float4*)(ap + 16 * s + 4));
                const bf16x8 bf = pack8v(*(const float4*)(bp + 16 * s), *(const float4*)(bp + 16 * s + 4));
                acc = MFMA(af, bf, acc);
            }
#pragma unroll
            for (int i = 0; i < 16; ++i) Bt4[(size_t)(hh * 128 + rt * 32 + crow(i, h2)) * 256 + kt * 32 + l31] = (bf16_t)(pk2(acc[i], 0.f) & 0xffffu);
        } else if (it < N_ADA + N_FA + N_FB) {
            const int wt = (it - N_ADA - N_FA) * 8 + w, g = wt >> 8, et = (wt >> 5) & 7, kt = wt & 31;
            f32x16 acc = zero16();
            const float* ap = p.pool_w + ((size_t)g * 256 + 8 * h2) * 256 + et * 32 + l31;
            const float* bp = p.e_w_in + (size_t)(kt * 32 + l31) * 5120 + 3072 + g * 256 + 8 * h2;
#pragma unroll 4
            for (int s = 0; s < 16; ++s) {
                const float* a = ap + (size_t)(16 * s) * 256;
                const bf16x8 af = pack8(a[0], a[256], a[512], a[768], a[1024], a[1280], a[1536], a[1792]);
                const bf16x8 bf = pack8v(*(const float4*)(bp + 16 * s), *(const float4*)(bp + 16 * s + 4));
                acc = MFMA(af, bf, acc);
            }
#pragma unroll
            for (int i = 0; i < 16; ++i) Bt1[(size_t)(3072 + g * 256 + et * 32 + crow(i, h2)) * 1024 + kt * 32 + l31] = (bf16_t)(pk2(acc[i], 0.f) & 0xffffu);
        } else {
            const int m = it - (N_ADA + N_FA + N_FB);
            if (m == 0) {
                uint4 z = {0u, 0u, 0u, 0u};
                uint4* d = (uint4*)(Bt3 + (size_t)2496 * 1024);
                for (int i = tid; i < 64 * 1024 / 8; i += NT) d[i] = z;
            } else {
                const int row = (m - 1) * 8 + w, t = row & 127;
                const float2 v = *(const float2*)(p.g_ws + (size_t)row * 128 + 2 * lane);
                const bool keep = (lane >> 5) <= (t >> 6);
                const unsigned u = keep ? pk2(v.x, v.y) : 0u;
                *(unsigned*)(Wsb + ((size_t)((((row >> 7) * 4 + (t >> 5)) * 8 + (lane >> 3)) * 2 + ((lane >> 2) & 1))) * 256 + (t & 31) * 8 + 2 * (lane & 3)) = u;
                const float sum = wsum(bflo(u) + bfhi(u));
                if (lane == 0) ((float*)(p.ws + OFF_RSW))[row] = sum;
            }
        }
    }
    __syncthreads();
    {
        float* tlw = (float*)smem + w * (64 * 65);
        const int gw = (int)gridDim.x * 8 - 1 - ((int)blockIdx.x * 8 + w);
        for (int tt = gw; tt < N_TR; tt += (int)gridDim.x * 8) {
            int t = tt;
            const float* src; int ld, K, c0, r0, kt; bf16_t* dst; bool rp = false, kp = false;
            if (t < 768) { src = p.e_w_in; ld = 5120; K = 1024; const int nt = t % 48; kt = t / 48; c0 = nt * 64; r0 = c0; dst = Bt1; }
            else if ((t -= 768) < 256) { src = p.e_w_in; ld = 5120; K = 1024; const int nt = t % 16; kt = t / 16; c0 = 4096 + nt * 64; r0 = c0; dst = Bt1; }
            else if ((t -= 256) < 512) { src = p.e_w_out; ld = 1024; K = 2048; const int nt = t % 16; kt = t / 16; c0 = nt * 64; r0 = c0; dst = Bt2; }
            else if ((t -= 512) < 512) { src = p.o_w_in; ld = 2496; K = 1024; const int nt = t % 32; kt = t / 32; c0 = 448 + nt * 64; r0 = nt * 64; dst = Bt3; }
            else if ((t -= 512) < 112) { src = p.o_w_in; ld = 2496; K = 1024; const int nt = t % 7; kt = t / 7; c0 = nt * 64; r0 = 2048 + nt * 64; dst = Bt3; }
            else if ((t -= 112) < 64) { src = p.w_uq; ld = 3072; K = 256; const int hh = t % 16; kt = t / 16; c0 = hh * 192 + 128; r0 = 2048 + hh * 64; dst = Bt4; rp = true; }
            else if ((t -= 64) < 64) { src = p.w_uv; ld = 2048; K = 128; const int nt = t % 32; kt = t / 32; c0 = nt * 64; r0 = c0; dst = Bt5; kp = true; }
            else { t -= 64; src = p.o_w_out; ld = 1024; K = 2048; const int nt = t % 16; kt = t / 16; c0 = nt * 64; r0 = c0; dst = Bt6; }
            transpose_tile_wave(src, ld, K, kt, c0, dst, r0, rp, kp, tlw, lane);
        }
    }
}

DI void phase1(const Params& p) {
    const float* mod = (const float*)(p.ws + OFF_MOD);
    bf16_t* h0 = (bf16_t*)(p.ws + OFF_H0);
    const int tid = tid_opaque();
    const size_t total = (size_t)T * 128, stride = (size_t)gridDim.x * NT;
    for (size_t base = (size_t)blockIdx.x * NT + tid; base < total; base += 4 * stride) {
        float4 xa[4], xb[4];
#pragma unroll
        for (int k = 0; k < 4; ++k) {
            const size_t idx = base + k * stride;
            if (idx < total) { const float* xp = p.x + idx * 8; const f32x4 a_ = __builtin_nontemporal_load((const f32x4*)xp), b_ = __builtin_nontemporal_load((const f32x4*)(xp + 4)); xa[k] = make_float4(a_[0], a_[1], a_[2], a_[3]); xb[k] = make_float4(b_[0], b_[1], b_[2], b_[3]); }
        }
#pragma unroll
        for (int k = 0; k < 4; ++k) {
            const size_t idx = base + k * stride;
            if (idx < total) {
                const int row = (int)(idx >> 7), col = ((int)idx & 127) * 8, b = row >> 12;
                const float* mp = mod + b * 3072 + col;
                const float4 sh0 = *(const float4*)mp, sh1 = *(const float4*)(mp + 4), sc0 = *(const float4*)(mp + 1024), sc1 = *(const float4*)(mp + 1028);
                const float4 x0 = xa[k], x1 = xb[k];
                uint4 o = {pk2(x0.x * (1.f + sc0.x) + sh0.x, x0.y * (1.f + sc0.y) + sh0.y), pk2(x0.z * (1.f + sc0.z) + sh0.z, x0.w * (1.f + sc0.w) + sh0.w),
                           pk2(x1.x * (1.f + sc1.x) + sh1.x, x1.y * (1.f + sc1.y) + sh1.y), pk2(x1.z * (1.f + sc1.z) + sh1.z, x1.w * (1.f + sc1.w) + sh1.w)};
                *(uint4*)(h0 + idx * 8) = o;
            }
        }
    }
}

template <int WIN>
DI void pool_rows(const bf16_t* __restrict__ proj, bf16_t* __restrict__ mix, const float* __restrict__ pool_b, const float* __restrict__ pool_s, int t0, int c0) {
    const int s0 = t0 & (SEQ - 1);
    const bf16_t* xp = proj + (size_t)t0 * 5120 + 3072 + c0;
    uint4 xr[WIN + 7], zr[8];
#pragma unroll
    for (int k = 0; k < WIN + 7; ++k) {
        const int dr = k - (WIN - 1);
        uint4 v = {0u, 0u, 0u, 0u};
        if (s0 + dr >= 0) v = *(const uint4*)(xp + (ptrdiff_t)dr * 5120);
        xr[k] = v;
    }
#pragma unroll
    for (int i = 0; i < 8; ++i) zr[i] = *(const uint4*)(xp + (size_t)i * 5120 + 1024);
    const float4 pb0 = *(const float4*)(pool_b + c0), pb1 = *(const float4*)(pool_b + c0 + 4);
    const float4 ps0 = *(const float4*)(pool_s + c0), ps1 = *(const float4*)(pool_s + c0 + 4);
    float a0 = 0.f, a1 = 0.f, a2 = 0.f, a3 = 0.f, a4 = 0.f, a5 = 0.f, a6 = 0.f, a7 = 0.f;
#pragma unroll
    for (int k = 0; k < WIN - 1; ++k) {
        const uint4 v = xr[k];
        a0 += bflo(v.x); a1 += bfhi(v.x); a2 += bflo(v.y); a3 += bfhi(v.y); a4 += bflo(v.z); a5 += bfhi(v.z); a6 += bflo(v.w); a7 += bfhi(v.w);
    }
#pragma unroll
    for (int i = 0; i < 8; ++i) {
        const uint4 xv = xr[WIN - 1 + i], zv = zr[i];
        a0 += bflo(xv.x); a1 += bfhi(xv.x); a2 += bflo(xv.y); a3 += bfhi(xv.y); a4 += bflo(xv.z); a5 += bfhi(xv.z); a6 += bflo(xv.w); a7 += bfhi(xv.w);
        const int cnt = min(s0 + i + 1, WIN);
        const float ic = 1.f / (float)cnt;
        const float o0 = ((a0 * ic - bflo(xv.x)) + pb0.x) * ps0.x * bflo(zv.x);
        const float o1 = ((a1 * ic - bfhi(xv.x)) + pb0.y) * ps0.y * bfhi(zv.x);
        const float o2 = ((a2 * ic - bflo(xv.y)) + pb0.z) * ps0.z * bflo(zv.y);
        const float o3 = ((a3 * ic - bfhi(xv.y)) + pb0.w) * ps0.w * bfhi(zv.y);
        const float o4 = ((a4 * ic - bflo(xv.z)) + pb1.x) * ps1.x * bflo(zv.z);
        const float o5 = ((a5 * ic - bfhi(xv.z)) + pb1.y) * ps1.y * bfhi(zv.z);
        const float o6 = ((a6 * ic - bflo(xv.w)) + pb1.z) * ps1.z * bflo(zv.w);
        const float o7 = ((a7 * ic - bfhi(xv.w)) + pb1.w) * ps1.w * bfhi(zv.w);
        uint4 o = {pk2(o0, o1), pk2(o2, o3), pk2(o4, o5), pk2(o6, o7)};
        *(uint4*)(mix + (size_t)(t0 + i) * 2048 + 1024 + c0) = o;
        const uint4 lv = xr[i];
        a0 -= bflo(lv.x); a1 -= bfhi(lv.x); a2 -= bflo(lv.y); a3 -= bfhi(lv.y); a4 -= bflo(lv.z); a5 -= bfhi(lv.z); a6 -= bflo(lv.w); a7 -= bfhi(lv.w);
    }
}

DI void phase3(const Params& p, char* smem, int it_lo, int it_hi) {
    const int tid = tid_opaque(), lane = tid & 63, w = tid >> 6, l31 = lane & 31, h2 = lane >> 5;
    const bf16_t* proj = (const bf16_t*)(p.ws + OFF_P0);
    bf16_t* mix = (bf16_t*)(p.ws + OFF_MIX);
    const bf16_t* Wsb = (const bf16_t*)(p.ws + OFF_WSB);
    const float* rsw = (const float*)(p.ws + OFF_RSW);
    const unsigned q4 = (lane & 15) >> 2, pp = lane & 3, lo = 2 * ((lane >> 4) & 1) + (pp >> 1);
    for (int it = it_lo + blockIdx.x; it < it_hi; it += gridDim.x) {
        if (it < 1024) {
            const int head = it & 3, nb = (it >> 2) & 31, b = it >> 7;
            const int t0 = b * SEQ + nb * 128;
            const int wt = w & 3, wd = w >> 2;
            bf16x8 wf[8];
            {
                const bf16_t* wp = Wsb + ((size_t)((head * 4 + wt) * 8) * 2 + h2) * 256 + l31 * 8;
#pragma unroll
                for (int kk = 0; kk < 8; ++kk) wf[kk] = *(const bf16x8*)(wp + 512 * kk);
            }
            const int crow_ = tid >> 5, cch = tid & 31;
            {
                const bf16_t* vp = proj + (size_t)(t0 + crow_) * 5120 + 1024 + head * 256 + cch * 8;
                uint4 rv[8];
#pragma unroll
                for (int i = 0; i < 8; ++i) rv[i] = *(const uint4*)(vp + (size_t)(16 * i) * 5120);
#pragma unroll
                for (int i = 0; i < 8; ++i) { const int row = 16 * i + crow_; *(uint4*)(smem + (row >> 5) * 16384 + (cch >> 4) * 8192 + off_b(row & 31, cch & 15)) = rv[i]; }
            }
            uint4 ur[8];
            {
                const bf16_t* up = proj + (size_t)(t0 + crow_) * 5120 + head * 256 + cch * 8;
#pragma unroll
                for (int i = 0; i < 8; ++i) ur[i] = *(const uint4*)(up + (size_t)(16 * i) * 5120);
            }
            __syncthreads();
            {
                const int row = tid >> 2, qd = tid & 3;
                char* ib = smem + (row >> 5) * 16384 + (qd >> 1) * 8192;
                uint4 rv[8];
#pragma unroll
                for (int i = 0; i < 8; ++i) rv[i] = *(const uint4*)(ib + off_b(row & 31, (qd & 1) * 8 + i));
                float sm = 0.f, sq = 0.f;
#pragma unroll
                for (int i = 0; i < 8; ++i) {
                    const float f0 = bflo(rv[i].x), f1 = bfhi(rv[i].x), f2 = bflo(rv[i].y), f3 = bfhi(rv[i].y), f4 = bflo(rv[i].z), f5 = bfhi(rv[i].z), f6 = bflo(rv[i].w), f7 = bfhi(rv[i].w);
                    sm += ((f0 + f1) + (f2 + f3)) + ((f4 + f5) + (f6 + f7));
                    sq += ((f0 * f0 + f1 * f1) + (f2 * f2 + f3 * f3)) + ((f4 * f4 + f5 * f5) + (f6 * f6 + f7 * f7));
                }
                sm += __shfl_xor(sm, 1); sq += __shfl_xor(sq, 1);
                sm += __shfl_xor(sm, 2); sq += __shfl_xor(sq, 2);
                const float mu = sm * (1.f / 256.f);
                const float rstd = rsqrtf(fmaxf(sq * (1.f / 256.f) - mu * mu, 0.f) + 1e-5f);
                const float nb_ = -mu * rstd;
#pragma unroll
                for (int i = 0; i < 8; ++i) {
                    uint4 o = {pk2(bflo(rv[i].x) * rstd + nb_, bfhi(rv[i].x) * rstd + nb_), pk2(bflo(rv[i].y) * rstd + nb_, bfhi(rv[i].y) * rstd + nb_),
                               pk2(bflo(rv[i].z) * rstd + nb_, bfhi(rv[i].z) * rstd + nb_), pk2(bflo(rv[i].w) * rstd + nb_, bfhi(rv[i].w) * rstd + nb_)};
                    *(uint4*)(ib + off_b(row & 31, (qd & 1) * 8 + i)) = o;
                }
            }
            uint4 zr[8];
            {
                const bf16_t* up = proj + (size_t)(t0 + crow_) * 5120 + head * 256 + cch * 8;
#pragma unroll
                for (int i = 0; i < 8; ++i) zr[i] = *(const uint4*)(up + (size_t)(16 * i) * 5120 + 2048);
            }
            __syncthreads();
            char* SV = smem + 65536;
            {
                f32x16 acc[4];
#pragma unroll
                for (int c = 0; c < 4; ++c) acc[c] = zero16();
                const int nks = wt < 2 ? 4 : 8;
                const char* vb = smem + wd * 8192 + 2048 * h2 + 256 * q4 + 8 * (pp & 1);
#pragma unroll
                for (int kk = 0; kk < 8; ++kk) {
                    if (kk < nks) {
                        const char* kb = vb + (kk >> 1) * 16384 + (kk & 1) * 4096;
#pragma unroll
                        for (int c = 0; c < 4; ++c) {
                            const uint2 t0v = tr_read(kb + 64 * (c ^ q4) + 16 * (lo ^ (2 * h2)));
                            const uint2 t1v = tr_read(kb + 1024 + 64 * (c ^ q4) + 16 * (lo ^ (2 * h2 + 1)));
                            acc[c] = MFMA(cat8(t0v, t1v), wf[kk], acc[c]);
                        }
                    }
                }
                const int tl = wt * 32 + l31;
                const float rs = rsw[head * 128 + tl];
                const float* gp = p.gn_g + wd * 128 + 4 * h2;
                const float* bp = p.gn_b + wd * 128 + 4 * h2;
                char* sp = SV + tl * 528 + (wd * 128 + 4 * h2) * 2;
#pragma unroll
                for (int dt = 0; dt < 4; ++dt)
#pragma unroll
                    for (int g = 0; g < 4; ++g) {
                        const float4 gg = *(const float4*)(gp + dt * 32 + 8 * g), gb = *(const float4*)(bp + dt * 32 + 8 * g);
                        uint2 o = {pkh2(gg.x * acc[dt][4 * g] + gb.x * rs, gg.y * acc[dt][4 * g + 1] + gb.y * rs),
                                   pkh2(gg.z * acc[dt][4 * g + 2] + gb.z * rs, gg.w * acc[dt][4 * g + 3] + gb.w * rs)};
                        *(uint2*)(sp + (dt * 32 + 8 * g) * 2) = o;
                    }
            }
            __syncthreads();
            {
                bf16_t* op = mix + (size_t)(t0 + crow_) * 2048 + head * 256 + cch * 8;
#pragma unroll
                for (int i = 0; i < 8; ++i) {
                    const int row = 16 * i + crow_;
                    const float bsv = p.g_bs[head * 128 + row];
                    const uint4 sv = *(const uint4*)(SV + row * 528 + cch * 16);
                    const uint4 uv = ur[i], zv = zr[i];
                    uint4 o = {pk2(bflo(uv.x) * (hlo(sv.x) + bsv) * bflo(zv.x), bfhi(uv.x) * (hhi(sv.x) + bsv) * bfhi(zv.x)),
                               pk2(bflo(uv.y) * (hlo(sv.y) + bsv) * bflo(zv.y), bfhi(uv.y) * (hhi(sv.y) + bsv) * bfhi(zv.y)),
                               pk2(bflo(uv.z) * (hlo(sv.z) + bsv) * bflo(zv.z), bfhi(uv.z) * (hhi(sv.z) + bsv) * bfhi(zv.z)),
                               pk2(bflo(uv.w) * (hlo(sv.w) + bsv) * bflo(zv.w), bfhi(uv.w) * (hhi(sv.w) + bsv) * bfhi(zv.w))};
                    *(uint4*)(op + (size_t)(16 * i) * 2048) = o;
                }
            }
        } else {
            const int rb = it - 1024;
            const int grp = w & 3, c0 = (grp * 32 + l31) * 8, t0 = rb * 32 + ((w >> 2) * 2 + h2) * 8;
            if (grp == 0) pool_rows<2>(proj, mix, p.pool_b, p.pool_s, t0, c0);
            else if (grp == 1) pool_rows<4>(proj, mix, p.pool_b, p.pool_s, t0, c0);
            else if (grp == 2) pool_rows<8>(proj, mix, p.pool_b, p.pool_s, t0, c0);
            else pool_rows<16>(proj, mix, p.pool_b, p.pool_s, t0, c0);
        }
    }
}

DI void ln_phase(float* io, const float* g, const float* bta, bf16_t* h, const float* mod  , float2* stats) {
    const int tid = tid_opaque(), lane = tid & 63, gw = blockIdx.x * (NT / 64) + (tid >> 6), nw = gridDim.x * (NT / 64);
    for (int row0 = gw; row0 < T; row0 += 2 * nw) {
        float4 v[2][4];
#pragma unroll
        for (int r = 0; r < 2; ++r) {
            const int row = row0 + r * nw;
            if (row < T) {
#pragma unroll
                for (int c = 0; c < 4; ++c) v[r][c] = *(const float4*)(io + (size_t)row * 1024 + 4 * lane + 256 * c);
            }
        }
#pragma unroll
        for (int r = 0; r < 2; ++r) {
            const int row = row0 + r * nw;
            if (row < T) {
                float* rp = io + (size_t)row * 1024 + 4 * lane;
                float s = 0.f;
#pragma unroll
                for (int c = 0; c < 4; ++c) s += v[r][c].x + v[r][c].y + v[r][c].z + v[r][c].w;
                const float mu = wsum(s) * (1.f / 1024.f);
                float q = 0.f;
#pragma unroll
                for (int c = 0; c < 4; ++c) { v[r][c].x -= mu; v[r][c].y -= mu; v[r][c].z -= mu; v[r][c].w -= mu; q += v[r][c].x * v[r][c].x + v[r][c].y * v[r][c].y + v[r][c].z * v[r][c].z + v[r][c].w * v[r][c].w; }
                const float rstd = rsqrtf(wsum(q) * (1.f / 1024.f) + 1e-5f);
                const int b = row >> 12;
                if (stats && lane == 0) stats[row] = make_float2(mu, rstd);
#pragma unroll
                for (int c = 0; c < 4; ++c) {
                    const int col = 4 * lane + 256 * c;
                    const float4 gv = *(const float4*)(g + col), bv = *(const float4*)(bta + col);
                    float4 o;
                    o.x = v[r][c].x * rstd * gv.x + bv.x; o.y = v[r][c].y * rstd * gv.y + bv.y; o.z = v[r][c].z * rstd * gv.z + bv.z; o.w = v[r][c].w * rstd * gv.w + bv.w;
                    if (!stats) { const f32x4 o_ = {o.x, o.y, o.z, o.w}; __builtin_nontemporal_store(o_, (f32x4*)(rp + 256 * c)); }
                    if (h) {
                        const float4 sh = *(const float4*)(mod + b * 3072 + col), sc = *(const float4*)(mod + b * 3072 + 1024 + col);
                        uint2 hv = {pk2(o.x * (1.f + sc.x) + sh.x, o.y * (1.f + sc.y) + sh.y), pk2(o.z * (1.f + sc.z) + sh.z, o.w * (1.f + sc.w) + sh.w)};
                        *(uint2*)(h + (size_t)row * 1024 + col) = hv;
                    }
                }
            }
        }
    }
}

DI void phase7(const Params& p, char* smem) {
    const int tid = tid_opaque(), lane = tid & 63, w = tid >> 6;
    const bf16_t* qc = (const bf16_t*)(p.ws + OFF_QC);
    const bf16_t* kvr = (const bf16_t*)(p.ws + OFF_KVR);
    bf16_t* qcn = (bf16_t*)(p.ws + OFF_QCN);
    bf16_t* Kb = (bf16_t*)(p.ws + OFF_KB);
    float* cosT = (float*)(p.ws + OFF_COS);
    float* sinT = (float*)(p.ws + OFF_SIN);
    for (int it = blockIdx.x; it < T / 64; it += gridDim.x) {
        const int t0 = it * 64;
        uint2 qv[8]; unsigned kvv[8]; int posv[8]; unsigned short k1v[8], k2v[8];
#pragma unroll
        for (int i = 0; i < 8; ++i) {
            const int t = t0 + w * 8 + i;
            qv[i] = *(const uint2*)(qc + (size_t)t * 256 + 4 * lane);
            kvv[i] = *(const unsigned*)(kvr + (size_t)t * 256 + 2 * lane);
            posv[i] = p.pos[t];
            k1v[i] = kvr[(size_t)t * 256 + 128 + (lane & 31)]; k2v[i] = kvr[(size_t)t * 256 + 160 + (lane & 31)];
        }
        const float4 gq = *(const float4*)(p.qn_g + 4 * lane);
        const float2 gk = *(const float2*)(p.kvn_g + 2 * lane);
        const double inv = exp2(-(double)(lane & 31) * (13.287712379549449 / 32.0));
#pragma unroll
        for (int i = 0; i < 8; ++i) {
            const int t = t0 + w * 8 + i;
            {
                const uint2 v = qv[i];
                const float f0 = bflo(v.x), f1 = bfhi(v.x), f2 = bflo(v.y), f3 = bfhi(v.y);
                const float rs = rsqrtf(wsum(f0 * f0 + f1 * f1 + f2 * f2 + f3 * f3) * (1.f / 256.f) + 1e-5f);
                uint2 o = {pk2(f0 * rs * gq.x, f1 * rs * gq.y), pk2(f2 * rs * gq.z, f3 * rs * gq.w)};
                *(uint2*)(qcn + (size_t)t * 256 + 4 * lane) = o;
            }
            {
                const unsigned v = kvv[i];
                const float f0 = bflo(v), f1 = bfhi(v);
                const float rs = rsqrtf(wsum(f0 * f0 + f1 * f1) * (1.f / 128.f) + 1e-5f);
                const unsigned o = pk2(f0 * rs * gk.x, f1 * rs * gk.y);
                *(unsigned*)(Kb + (size_t)t * 192 + 2 * lane) = o;
            }
            if (lane < 32) {
                const double ang = (double)posv[i] * inv;
                const double n = rint(ang * 0.15915494309189535);
                const float rr = (float)(ang - n * 6.283185307179586);
                float sn, cs;
                sincosf(rr, &sn, &cs);
                cosT[(size_t)t * 32 + lane] = cs; sinT[(size_t)t * 32 + lane] = sn;
                const float x1 = bf2f(k1v[i]), x2 = bf2f(k2v[i]);
                Kb[(size_t)t * 192 + 128 + lane] = (bf16_t)(pk2(x1 * cs - x2 * sn, 0.f) & 0xffffu);
                Kb[(size_t)t * 192 + 160 + lane] = (bf16_t)(pk2(x2 * cs + x1 * sn, 0.f) & 0xffffu);
            }
        }
    }
}

constexpr int ATT_ROPE_OFF = 16384, ATT_STAGE_B = 24576;
typedef unsigned long long u64_t;
#define TR8_ISSUE(R, OFF) asm volatile( \
    "ds_read_b64_tr_b16 %0, %8 offset:%16\n\tds_read_b64_tr_b16 %1, %9 offset:%16\n\tds_read_b64_tr_b16 %2, %10 offset:%16\n\tds_read_b64_tr_b16 %3, %11 offset:%16\n\t" \
    "ds_read_b64_tr_b16 %4, %12 offset:%16\n\tds_read_b64_tr_b16 %5, %13 offset:%16\n\tds_read_b64_tr_b16 %6, %14 offset:%16\n\tds_read_b64_tr_b16 %7, %15 offset:%16" \
    : "=&v"(R[0]), "=&v"(R[1]), "=&v"(R[2]), "=&v"(R[3]), "=&v"(R[4]), "=&v"(R[5]), "=&v"(R[6]), "=&v"(R[7]) \
    : "v"(va[0]), "v"(va[1]), "v"(va[2]), "v"(va[3]), "v"(va[4]), "v"(va[5]), "v"(va[6]), "v"(va[7]), "i"(OFF))
#define TR8_WAIT(R, N) asm volatile("s_waitcnt lgkmcnt(%8)" \
    : "+v"(R[0]), "+v"(R[1]), "+v"(R[2]), "+v"(R[3]), "+v"(R[4]), "+v"(R[5]), "+v"(R[6]), "+v"(R[7]) : "i"(N))
DI bf16x8 cat8u(u64_t lo, u64_t hi) { typedef u64_t u64x2 __attribute__((ext_vector_type(2))); u64x2 u = {lo, hi}; return __builtin_bit_cast(bf16x8, u); }
template <int BUF>
DI void att_tile(char* smem, const bf16x8 (&qf)[12], f32x16 (&oacc)[4], float& m, float& l, unsigned rowA0, unsigned ropeA0, const unsigned (&va)[8]) {
    constexpr int SB = BUF * ATT_STAGE_B;
    const char* sb = smem + SB;
    asm volatile("" : "+v"(rowA0), "+v"(ropeA0));
    f32x16 s0 = zero16(), s1 = zero16();
    bf16x8 ka0 = *(const bf16x8*)(sb + rowA0), ka1 = *(const bf16x8*)(sb + 8192 + rowA0);
#pragma unroll
    for (int kk = 0; kk < 12; ++kk) {
        bf16x8 kb0 = ka0, kb1 = ka1;
        if (kk + 1 < 8) { kb0 = *(const bf16x8*)(sb + (rowA0 ^ (32u * (kk + 1)))); kb1 = *(const bf16x8*)(sb + 8192 + (rowA0 ^ (32u * (kk + 1)))); }
        else if (kk + 1 < 12) { kb0 = *(const bf16x8*)(sb + (ropeA0 ^ (32u * (kk - 7)))); kb1 = *(const bf16x8*)(sb + 4096 + (ropeA0 ^ (32u * (kk - 7)))); }
        s0 = MFMA(ka0, qf[kk], s0);
        s1 = MFMA(ka1, qf[kk], s1);
        ka0 = kb0; ka1 = kb1;
    }
    u64_t ra[8], rb[8];
    TR8_ISSUE(ra, SB);
    float mx = fmaxf(s0[0], s1[0]);
#pragma unroll
    for (int i = 1; i < 16; ++i) mx = fmaxf(mx, fmaxf(s0[i], s1[i]));
    {
        const auto r_ = __builtin_amdgcn_permlane32_swap(__float_as_uint(mx), __float_as_uint(mx), false, false);
        mx = fmaxf(__uint_as_float(r_[0]), __uint_as_float(r_[1]));
    }
    if (__any(mx > m + 8.f)) {
        const float mn = fmaxf(m, mx);
        const float alpha = __builtin_amdgcn_exp2f(m - mn);
        m = mn;
        l *= alpha;
#pragma unroll
        for (int dt = 0; dt < 4; ++dt)
#pragma unroll
            for (int i = 0; i < 16; ++i) oacc[dt][i] *= alpha;
    }
    float ls0 = 0.f, ls1 = 0.f;
#pragma unroll
    for (int i = 0; i < 16; ++i) { s0[i] = __builtin_amdgcn_exp2f(s0[i] - m); ls0 += s0[i]; }
#pragma unroll
    for (int i = 0; i < 16; ++i) { s1[i] = __builtin_amdgcn_exp2f(s1[i] - m); ls1 += s1[i]; }
    l += ls0 + ls1;
    bf16x8 pf[4];
    pf[0] = pack8(s0[0], s0[1], s0[2], s0[3], s0[4], s0[5], s0[6], s0[7]);
    pf[1] = pack8(s0[8], s0[9], s0[10], s0[11], s0[12], s0[13], s0[14], s0[15]);
    pf[2] = pack8(s1[0], s1[1], s1[2], s1[3], s1[4], s1[5], s1[6], s1[7]);
    pf[3] = pack8(s1[8], s1[9], s1[10], s1[11], s1[12], s1[13], s1[14], s1[15]);
    TR8_ISSUE(rb, SB + 4096);
    TR8_WAIT(ra, 8);
#pragma unroll
    for (int dt = 0; dt < 4; ++dt) oacc[dt] = MFMA(cat8u(ra[2 * dt], ra[2 * dt + 1]), pf[0], oacc[dt]);
    TR8_ISSUE(ra, SB + 8192);
    TR8_WAIT(rb, 8);
#pragma unroll
    for (int dt = 0; dt < 4; ++dt) oacc[dt] = MFMA(cat8u(rb[2 * dt], rb[2 * dt + 1]), pf[1], oacc[dt]);
    TR8_ISSUE(rb, SB + 8192 + 4096);
    TR8_WAIT(ra, 8);
#pragma unroll
    for (int dt = 0; dt < 4; ++dt) oacc[dt] = MFMA(cat8u(ra[2 * dt], ra[2 * dt + 1]), pf[2], oacc[dt]);
    TR8_WAIT(rb, 0);
#pragma unroll
    for (int dt = 0; dt < 4; ++dt) oacc[dt] = MFMA(cat8u(rb[2 * dt], rb[2 * dt + 1]), pf[3], oacc[dt]);
}

DI void phase9(const Params& p, char* smem) {
    const int tid = tid_opaque(), lane = tid & 63, w = tid >> 6, l31 = lane & 31, h2 = lane >> 5;
    const bf16_t* Q = (const bf16_t*)(p.ws + OFF_Q);
    const bf16_t* Kb = (const bf16_t*)(p.ws + OFF_KB);
    const bf16_t* Bt5 = (const bf16_t*)(p.ws + OFF_BT5);
    const bf16_t* zs = (const bf16_t*)(p.ws + OFF_ZS);
    bf16_t* og = (bf16_t*)(p.ws + OFF_MIX);
    constexpr int ROPE_OFF = ATT_ROPE_OFF, RRS = 128, STAGE = ATT_STAGE_B;
    const unsigned xr = ((l31 & 3) << 2) | ((l31 >> 2) & 3);
    const unsigned rowA0 = 256u * l31 + 16u * (h2 ^ (xr & 1)) + 32u * (xr >> 1);
    const unsigned xr2 = (l31 >> 1) & 7;
    const unsigned ropeA0 = ROPE_OFF + l31 * RRS + 16u * (h2 ^ (xr2 & 1)) + 16u * (xr2 & 6);
    const unsigned q4 = (lane & 15) >> 2, pp = lane & 3, lo = 2 * ((lane >> 4) & 1) + (pp >> 1);
    unsigned va[8];
    {
        const unsigned vbase = (unsigned)(size_t)smem + 1024u * h2 + 256u * q4 + 8u * (pp & 1);
#pragma unroll
        for (int dt = 0; dt < 4; ++dt) { va[2 * dt] = vbase + 64u * (dt ^ q4) + 16u * (lo ^ h2); va[2 * dt + 1] = vbase + 2048u + 64u * (dt ^ q4) + 16u * (lo ^ (2u + h2)); }
    }
    const int G = gridDim.x;
    for (int j = 0;; ++j) {
        const int ii = (j & 1) ? (j * G + (G - 1 - (int)blockIdx.x)) : (j * G + (int)blockIdx.x);
        if (j * G >= 2048) break;
        if (ii >= 2048) continue;
        const int qb = 31 - (ii >> 6), bh = ii & 63, b = bh & 7, hh = (bh >> 3) * 2 + (w >> 2);
        const int trow = b * SEQ + qb * 128 + (w & 3) * 32 + l31;
        bf16x8 qf[12];
        {
            const bf16_t* qp = Q + qfo(trow, hh, 8 * h2);
#pragma unroll
            for (int kk = 0; kk < 12; ++kk) qf[kk] = *(const bf16x8*)(qp + 512 * kk);
        }
        f32x16 oacc[4];
#pragma unroll
        for (int dt = 0; dt < 4; ++dt) oacc[dt] = zero16();
        float m = -1e30f, l = 0.f;
        const int nkt = 2 * qb + 2, wl = 2 * qb + ((w & 3) >> 1);
        const bf16_t* Kbb = Kb + (size_t)b * SEQ * 192;
        unsigned ko0, ko1, ko2;
        {
            const unsigned sa = (unsigned)(w * 64 + lane), sb_ = sa + 512;
            const unsigned ra = (sa >> 4) & 31, rb_ = (sb_ >> 4) & 31;
            ko0 = 2 * (((sa >> 9) * 32 + ra) * 192 + 8 * ((sa & 15) ^ (((ra & 3) << 2) | ((ra >> 2) & 3))));
            ko1 = 2 * (((sb_ >> 9) * 32 + rb_) * 192 + 8 * ((sb_ & 15) ^ (((rb_ & 3) << 2) | ((rb_ >> 2) & 3))));
            const unsigned rr = sa >> 3;
            ko2 = 2 * (rr * 192 + 128 + 8 * ((sa & 7) ^ ((rr >> 1) & 7)));
        }
#define ATT_STAGE(buf_, kt_) do { const char* g_ = (const char*)(Kbb + (size_t)(kt_) * 64 * 192); LAS unsigned* d_ = (LAS unsigned*)(smem + (buf_) * STAGE + w * 1024);             __builtin_amdgcn_global_load_lds((const unsigned*)(g_ + ko0), d_, 16, 0, 0);             __builtin_amdgcn_global_load_lds((const unsigned*)(g_ + ko1), d_ + 2048, 16, 0, 0);             __builtin_amdgcn_global_load_lds((const unsigned*)(g_ + ko2), d_ + 4096, 16, 0, 0); } while (0)
        ATT_STAGE(0, 0);
        __syncthreads();
        for (int kt = 0; kt < nkt; kt += 2) {
            ATT_STAGE(1, kt + 1);
            if (kt <= wl) att_tile<0>(smem, qf, oacc, m, l, rowA0, ropeA0, va);
            __syncthreads();
            if (kt + 2 < nkt) ATT_STAGE(0, kt + 2);
            if (kt + 1 <= wl) att_tile<1>(smem, qf, oacc, m, l, rowA0, ropeA0, va);
            __syncthreads();
        }
#undef ATT_STAGE
        const float inv = 1.f / (l + __shfl_xor(l, 32));
        const int te_ = tid_opaque(), l31e = te_ & 31, h2e = (te_ >> 5) & 1, we = te_ >> 6;
        const int trowe = b * SEQ + qb * 128 + (we & 3) * 32 + l31e;
        const int rr = (te_ >> 4) & 3, ch = te_ & 15;
        const int trow0 = b * SEQ + qb * 128 + (we & 3) * 32;
        const bf16_t* zp = zs + ((size_t)((trow0 >> 12) * 16 + hh) * SEQ + (trow0 & (SEQ - 1)) + rr) * 128 + ch * 8;
        const uint4 zq0 = *(const uint4*)(zp), zq1 = *(const uint4*)(zp + 512), zq2 = *(const uint4*)(zp + 1024), zq3 = *(const uint4*)(zp + 1536);
        const uint4 zq4 = *(const uint4*)(zp + 2048), zq5 = *(const uint4*)(zp + 2560), zq6 = *(const uint4*)(zp + 3072), zq7 = *(const uint4*)(zp + 3584);
        bf16x8 of[8];
#pragma unroll
        for (int dt = 0; dt < 4; ++dt) {
            of[2 * dt] = pack8(oacc[dt][0] * inv, oacc[dt][1] * inv, oacc[dt][2] * inv, oacc[dt][3] * inv, oacc[dt][4] * inv, oacc[dt][5] * inv, oacc[dt][6] * inv, oacc[dt][7] * inv);
            of[2 * dt + 1] = pack8(oacc[dt][8] * inv, oacc[dt][9] * inv, oacc[dt][10] * inv, oacc[dt][11] * inv, oacc[dt][12] * inv, oacc[dt][13] * inv, oacc[dt][14] * inv, oacc[dt][15] * inv);
        }
        char* ot = smem + 49152 + we * 8704;
#pragma unroll
        for (int d2 = 0; d2 < 4; ++d2) {
            f32x16 o = zero16();
            const bf16_t* wp = Bt5 + ((size_t)((hh * 4 + d2) * 8) * 2 + h2e) * 256 + l31e * 8;
#pragma unroll
            for (int ks = 0; ks < 8; ++ks) {
                o = MFMA(*(const bf16x8*)(wp + 512 * ks), of[ks], o);
            }
#pragma unroll
            for (int g = 0; g < 2; ++g) {
                uint4 hv = {pkh2(o[8 * g], o[8 * g + 1]), pkh2(o[8 * g + 2], o[8 * g + 3]), pkh2(o[8 * g + 4], o[8 * g + 5]), pkh2(o[8 * g + 6], o[8 * g + 7])};
                *(uint4*)(ot + l31e * 272 + (16 * h2e + d2 * 32 + 8 * g) * 2) = hv;
            }
        }
        {
            bf16_t* op = og + (size_t)(trow0 + rr) * 2048 + hh * 128 + ch * 8;
            const char* orow = ot + rr * 272 + ch * 16;
#define ATT_FIN(pi, zv) do { const uint4 ov = *(const uint4*)(orow + (pi) * 4 * 272); \
                uint4 r = {pk2(hlo(ov.x) * bflo(zv.x), hhi(ov.x) * bfhi(zv.x)), pk2(hlo(ov.y) * bflo(zv.y), hhi(ov.y) * bfhi(zv.y)), \
                           pk2(hlo(ov.z) * bflo(zv.z), hhi(ov.z) * bfhi(zv.z)), pk2(hlo(ov.w) * bflo(zv.w), hhi(ov.w) * bfhi(zv.w))}; \
                *(uint4*)(op + (size_t)(pi) * 4 * 2048) = r; } while (0)
            ATT_FIN(0, zq0); ATT_FIN(1, zq1); ATT_FIN(2, zq2); ATT_FIN(3, zq3); ATT_FIN(4, zq4); ATT_FIN(5, zq5); ATT_FIN(6, zq6); ATT_FIN(7, zq7);
#undef ATT_FIN
        }
    }
}

#define XB_TMO      128
#define XB_XCNT(j)  (256  + 64 * (j))
#define XB_XSUB(j)  (1280 + 64 * (j))
#define XB_XGEN(j)  (2304 + 64 * (j))
#define XB_TOP      3328
#define XB_TOPGEN   3392
#define XCD_BAR_WORDS 3456
#define XB_SPIN_CAP (1u << 18)
DI unsigned xb_ld(unsigned* p)              { return __hip_atomic_load(p, __ATOMIC_RELAXED, __HIP_MEMORY_SCOPE_AGENT); }
DI unsigned xb_add(unsigned* p, unsigned v) { return __hip_atomic_fetch_add(p, v, __ATOMIC_RELAXED, __HIP_MEMORY_SCOPE_AGENT); }
DI unsigned xb_xcc_id() { return (unsigned)__builtin_amdgcn_s_getreg((3 << 11) | 20) & 0xFu; }
#define XB_SPIN(cond, bar) do { unsigned _sp = 0; while (cond) { __builtin_amdgcn_s_sleep(1); \
    if ((++_sp & 255u) == 0u) { if (xb_ld(&(bar)[XB_TMO])) break; if (_sp > XB_SPIN_CAP) { atomicAdd(&(bar)[XB_TMO], 1u); break; } } } } while (0)
struct XcdBarrier { unsigned* bar; unsigned x; volatile LAS unsigned* st; };
DI XcdBarrier xcd_barrier_post(unsigned* bar, volatile LAS unsigned* st) {
    XcdBarrier b; b.bar = bar; b.x = xb_xcc_id(); b.st = st;
    if (threadIdx.x == 0) (void)xb_add(&bar[XB_XCNT(b.x)], 1u);
    return b;
}
DI void xcd_barrier_complete(unsigned* bar, unsigned x, unsigned& nloc, unsigned& nx) {
    const unsigned G = gridDim.x * gridDim.y * gridDim.z;
    unsigned sum, cnt, mine, sp = 0u;
    for (;;) {
        sum = 0u; cnt = 0u; mine = 0u;
#pragma unroll
        for (unsigned j = 0; j < 16; ++j) { const unsigned c = xb_ld(&bar[XB_XCNT(j)]); sum += c; cnt += (c > 0u) ? 1u : 0u; mine = (j == x) ? c : mine; }
        if (sum == G) break;
        __builtin_amdgcn_s_sleep(1);
        if ((++sp & 255u) == 0u) { if (xb_ld(&bar[XB_TMO])) break; if (sp > XB_SPIN_CAP) { atomicAdd(&bar[XB_TMO], 1u); break; } }
    }
    nloc = mine > 0u ? mine : 1u; nx = cnt > 0u ? cnt : 1u;
}
DI void xcd_barrier(const XcdBarrier& b) {
    asm volatile("s_waitcnt vmcnt(0)" ::: "memory");
    __syncthreads();
    if (threadIdx.x == 0) {
        unsigned* bar = b.bar;
        __builtin_amdgcn_s_waitcnt(0);
        unsigned nloc = b.st[0], nx = b.st[1];
        if (nloc == 0u) { xcd_barrier_complete(bar, b.x, nloc, nx); b.st[0] = nloc; b.st[1] = nx; }
        const unsigned old = xb_add(&bar[XB_XSUB(b.x)], 1u);
        const unsigned gen = old / nloc;
        if (old + 1u == (gen + 1u) * nloc) {
            __builtin_amdgcn_fence(__ATOMIC_RELEASE, "agent");
            asm volatile("s_waitcnt vmcnt(0)" ::: "memory");
            const unsigned og = xb_add(&bar[XB_TOP], 1u);
            const unsigned tg = og / nx;
            if (og + 1u == (tg + 1u) * nx) xb_add(&bar[XB_TOPGEN], 1u);
            else XB_SPIN(xb_ld(&bar[XB_TOPGEN]) == tg, bar);
            __builtin_amdgcn_fence(__ATOMIC_ACQUIRE, "agent");
            xb_add(&bar[XB_XGEN(b.x)], 1u);
            asm volatile("s_waitcnt vmcnt(0)" ::: "memory");
        } else {
            XB_SPIN(xb_ld(&bar[XB_XGEN(b.x)]) == gen, bar);
            __builtin_amdgcn_fence(__ATOMIC_ACQUIRE, "agent");
            asm volatile("s_waitcnt vmcnt(0)" ::: "memory");
        }
    }
    __syncthreads();
}

template <class Epi>
DI void run_gemm(const bf16_t* A, const bf16_t* Bt, int N, int K, const Epi& e, char* smem) {
    pg8::Gemm g{A, Bt, T, N, K};
    pg8::StaticOrder so; so.init(T, N, (int)gridDim.x, (int)blockIdx.x);
    pg8::gemm_phase((PG8_LAS unsigned char*)smem, g, so, e);
    __syncthreads();
}
template <int PH>
DI void run_phase(const Params& p, char* smem) {
    char* ws = p.ws;
    float* mod = (float*)(ws + OFF_MOD);
    if (PH == 0) phase0(p, smem);
    if (PH == 1) phase1(p);
    if (PH == 2) { Epi1 e{(bf16_t*)(ws + OFF_P0)}; run_gemm((const bf16_t*)(ws + OFF_H0), (const bf16_t*)(ws + OFF_BT1), 5120, 1024, e, smem); }
    if (PH == 3) phase3(p, smem, 0, 2048);
    if (PH == 4) { EpiRes e{p.x, p.out, mod + 2048}; run_gemm((const bf16_t*)(ws + OFF_MIX), (const bf16_t*)(ws + OFF_BT2), 1024, 2048, e, smem); }
    if (PH == 5) ln_phase(p.out, p.ln_g, p.ln_b, (bf16_t*)(ws + OFF_H1), mod + 8 * 3072, (float2*)(ws + OFF_STATS));
    if (PH == 6) { Epi3 e{(bf16_t*)(ws + OFF_ZS), (bf16_t*)(ws + OFF_QC), (bf16_t*)(ws + OFF_KVR)}; run_gemm((const bf16_t*)(ws + OFF_H1), (const bf16_t*)(ws + OFF_BT3), 2560, 1024, e, smem); }
    if (PH == 7) phase7(p, smem);
    if (PH == 8) { Epi4 e{(bf16_t*)(ws + OFF_Q), (const float*)(ws + OFF_COS), (const float*)(ws + OFF_SIN)}; run_gemm((const bf16_t*)(ws + OFF_QCN), (const bf16_t*)(ws + OFF_BT4), 3072, 256, e, smem); }
    if (PH == 9) phase9(p, smem);
    if (PH == 10) { EpiResLn e{p.out, (const float2*)(ws + OFF_STATS), p.ln_g, p.ln_b, mod + 8 * 3072 + 2048}; run_gemm((const bf16_t*)(ws + OFF_MIX), (const bf16_t*)(ws + OFF_BT6), 1024, 2048, e, smem); }
    if (PH == 11) ln_phase(p.out, p.ln_g + 1024, p.ln_b + 1024, nullptr, nullptr, nullptr);
}

extern __shared__ __attribute__((aligned(16))) char dyn_smem[];

__global__ void __launch_bounds__(NT) fwd_megakernel(Params p) {
    cg::grid_group grid = cg::this_grid();
    volatile LAS unsigned* st = (volatile LAS unsigned*)((LAS unsigned char*)dyn_smem + (LDS_BYTES - 16));
    if (threadIdx.x == 0) { st[0] = 0u; st[1] = 0u; }
    __syncthreads();
    const XcdBarrier xb = xcd_barrier_post((unsigned*)(p.ws + OFF_BAR), st);
    if (p.out == nullptr) grid.sync();
    run_phase<0>(p, dyn_smem); xcd_barrier(xb);
    run_phase<1>(p, dyn_smem); xcd_barrier(xb);
    run_phase<2>(p, dyn_smem); xcd_barrier(xb);
    run_phase<3>(p, dyn_smem); xcd_barrier(xb);
    run_phase<4>(p, dyn_smem); xcd_barrier(xb);
    run_phase<5>(p, dyn_smem); xcd_barrier(xb);
    run_phase<6>(p, dyn_smem); xcd_barrier(xb);
    run_phase<7>(p, dyn_smem); xcd_barrier(xb);
    run_phase<8>(p, dyn_smem); xcd_barrier(xb);
    run_phase<9>(p, dyn_smem); xcd_barrier(xb);
    run_phase<10>(p, dyn_smem); xcd_barrier(xb);
    run_phase<11>(p, dyn_smem);
}

extern "C" void kernel_launch(void* const* d_in, const int* in_sizes, int n_in, void* d_out, int out_size, void* d_ws, size_t ws_size, hipStream_t stream) {
    static int grid_blocks = 0;
    if (!grid_blocks) {
        hipFuncSetAttribute((const void*)fwd_megakernel, hipFuncAttributeMaxDynamicSharedMemorySize, LDS_BYTES);
        int dev = 0, cus = 0, per_cu = 0;
        hipGetDevice(&dev);
        hipDeviceGetAttribute(&cus, hipDeviceAttributeMultiprocessorCount, dev);
        hipOccupancyMaxActiveBlocksPerMultiprocessor(&per_cu, fwd_megakernel, NT, LDS_BYTES);
        if (per_cu < 1) per_cu = 1;
        grid_blocks = cus * 1;
    }
    if (ws_size < WS_NEED) { fprintf(stderr, "workspace too small: %zu < %zu\n", ws_size, (size_t)WS_NEED); return; }
    Params p{};
    p.x = (const float*)d_in[0]; p.c = (const float*)d_in[1]; p.pos = (const int*)d_in[2];
    p.ada_w = (const float*)d_in[3]; p.ada_b = (const float*)d_in[4]; p.ln_g = (const float*)d_in[5]; p.ln_b = (const float*)d_in[6];
    p.e_w_in = (const float*)d_in[7]; p.gn_g = (const float*)d_in[8]; p.gn_b = (const float*)d_in[9]; p.g_ws = (const float*)d_in[10]; p.g_bs = (const float*)d_in[11];
    p.pool_w = (const float*)d_in[12]; p.pool_b = (const float*)d_in[13]; p.pool_s = (const float*)d_in[14]; p.e_w_out = (const float*)d_in[15];
    p.o_w_in = (const float*)d_in[16]; p.qn_g = (const float*)d_in[17]; p.kvn_g = (const float*)d_in[18]; p.w_uq = (const float*)d_in[19];
    p.w_uk = (const float*)d_in[20]; p.w_uv = (const float*)d_in[21]; p.o_w_out = (const float*)d_in[22];
    p.out = (float*)d_out; p.ws = (char*)d_ws;
    hipMemsetAsync((char*)d_ws + OFF_BAR, 0, XCD_BAR_WORDS * sizeof(unsigned), stream);
    void* args[] = {&p};
    hipError_t e = hipLaunchCooperativeKernel((const void*)fwd_megakernel, dim3(grid_blocks), dim3(NT), args, LDS_BYTES, stream);
    if (e != hipSuccess) fprintf(stderr, "cooperative launch failed: %s (grid %d)\n", hipGetErrorString(e), grid_blocks);
}
```
